# Optimizing an MI355X kernel written in HIP

```python
import jax, jax.numpy as jnp
from jax import lax
import numpy as np

D_MODEL = 1024
BATCH = 2
SEQ = 8192
DEPTH = 2

N_META = 16
MIX_WIDTH = D_MODEL
POOL_WIDTH = MIX_WIDTH // 2
POOL_GROUPS = 4
POOL_GROUP_DIM = POOL_WIDTH // POOL_GROUPS
POOL_WINDOWS = (2, 4, 8, 16)
GLA_WIDTH = MIX_WIDTH - POOL_WIDTH
GLA_HEADS = 4
GLA_KEY_WIDTH = GLA_WIDTH // 2
GLA_DK = GLA_KEY_WIDTH // GLA_HEADS
GLA_DV = GLA_WIDTH // GLA_HEADS
GLA_GATE_RANK = 16
GLA_GATE_TEMP = 16.0
GLA_CHUNK = 64
GLA_PAD = GLA_CHUNK - N_META
D_FF = 2816
IN_PROJ_COLS = POOL_WIDTH + 2 * GLA_KEY_WIDTH + 2 * GLA_WIDTH + GLA_GATE_RANK
DEEPNORM_ALPHA = (2.0 * DEPTH) ** 0.25
DEEPNORM_BETA = (8.0 * DEPTH) ** -0.25
LN_EPS = 1e-5
RMS_EPS = 1e-6

kernel_name = "hymba_pool_gla_macaron_deepnorm"


def layer_norm(x, g, b):
    xf = x.astype(jnp.float32)
    mu = jnp.mean(xf, axis=-1, keepdims=True)
    var = jnp.mean(jnp.square(xf - mu), axis=-1, keepdims=True)
    y = (xf - mu) * lax.rsqrt(var + LN_EPS)
    return (y * g.astype(jnp.float32) + b.astype(jnp.float32)).astype(x.dtype)


def swiglu(x, w_gate, w_up, w_down):
    return (jax.nn.silu(x @ w_gate) * (x @ w_up)) @ w_down


def pool_mixer(u, w_pool, pool_scale):
    B_, T, _ = u.shape
    uf = u.astype(jnp.float32)
    cs = jnp.cumsum(uf, axis=1)
    t = jnp.arange(T)
    outs = []
    for gi, w in enumerate(POOL_WINDOWS):
        sl = slice(gi * POOL_GROUP_DIM, (gi + 1) * POOL_GROUP_DIM)
        c = cs[..., sl]
        shifted = jnp.pad(c, ((0, 0), (w, 0), (0, 0)))[:, :T]
        cnt = jnp.minimum(t + 1, w).astype(jnp.float32)
        mean = (c - shifted) / cnt[None, :, None]
        outs.append(mean - uf[..., sl])
    p = jnp.stack(outs, axis=2).astype(u.dtype)
    p = jnp.einsum('btgc,gcd->btgd', p, w_pool).reshape(B_, T, POOL_WIDTH)
    return p * pool_scale


def gla_chunked(q, k, v, log_a):
    B_, H, Tp, dk = q.shape
    dv = v.shape[-1]
    n = Tp // GLA_CHUNK

    def chunks(z):
        return jnp.moveaxis(z.reshape(B_, H, n, GLA_CHUNK, z.shape[-1]), 2, 0)

    mask = jnp.tril(jnp.ones((GLA_CHUNK, GLA_CHUNK), dtype=bool))[:, :, None]

    def step(S, xs):
        qc, kc, vc, gc = xs
        b = jnp.cumsum(gc, axis=2)
        o_inter = jnp.einsum('bhid,bhde->bhie', qc * jnp.exp(b), S)
        diff = b[:, :, :, None, :] - b[:, :, None, :, :]
        decay = jnp.where(mask, jnp.exp(jnp.where(mask, diff, 0.0)), 0.0)
        A = jnp.einsum('bhid,bhjd,bhijd->bhij', qc, kc, decay)
        o_intra = jnp.einsum('bhij,bhje->bhie', A, vc)
        b_last = b[:, :, -1:, :]
        S_new = S * jnp.exp(b_last[:, :, 0, :])[..., None] + jnp.einsum(
            'bhjd,bhje->bhde', kc * jnp.exp(b_last - b), vc)
        return S_new, o_inter + o_intra

    S0 = jnp.zeros((B_, H, dk, dv), jnp.float32)
    _, o = lax.scan(step, S0, (chunks(q), chunks(k), chunks(v), chunks(log_a)))
    return jnp.moveaxis(o, 0, 2).reshape(B_, H, Tp, dv)


def gla_mixer(q, k, v, r, g_lr, w_gate_up, b_gate, gla_norm_g):
    B_, T, _ = q.shape
    log_a = jax.nn.log_sigmoid((g_lr @ w_gate_up + b_gate).astype(jnp.float32)) / GLA_GATE_TEMP

    def heads(z, d):
        z = z.astype(jnp.float32).reshape(B_, T, GLA_HEADS, d).transpose(0, 2, 1, 3)
        return jnp.pad(z, ((0, 0), (0, 0), (GLA_PAD, 0), (0, 0)))

    qh = heads(q, GLA_DK) * (GLA_DK ** -0.5)
    kh = heads(k, GLA_DK)
    vh = heads(v, GLA_DV)
    gh = heads(log_a, GLA_DK)
    o = gla_chunked(qh, kh, vh, gh)[:, :, GLA_PAD:]
    o = o.transpose(0, 2, 1, 3)
    o = o * lax.rsqrt(jnp.mean(jnp.square(o), axis=-1, keepdims=True) + RMS_EPS)
    o = o.reshape(B_, T, GLA_WIDTH) * gla_norm_g.astype(jnp.float32)
    return (o * jax.nn.silu(r.astype(jnp.float32))).astype(q.dtype)


def setup_inputs(seed: int = 0) -> dict:
    key = jax.random.key(seed)
    ks = jax.random.split(key, 24)
    f32 = jnp.float32

    def nrm(k, shape, scale):
        return jax.random.normal(k, shape, f32) * scale

    L = DEPTH
    return {
        "x": nrm(ks[0], (BATCH, SEQ, D_MODEL), 1.0),
        "meta_tokens": nrm(ks[1], (N_META, D_MODEL), 1.0),
        "ffn1_w_gate": nrm(ks[2], (L, D_MODEL, D_FF), D_MODEL ** -0.5),
        "ffn1_w_up": nrm(ks[3], (L, D_MODEL, D_FF), D_MODEL ** -0.5),
        "ffn1_w_down": nrm(ks[4], (L, D_FF, D_MODEL), DEEPNORM_BETA * D_FF ** -0.5),
        "ln1_g": 1.0 + nrm(ks[5], (L, D_MODEL), 0.02),
        "ln1_b": nrm(ks[6], (L, D_MODEL), 0.02),
        "w_in": nrm(ks[7], (L, D_MODEL, IN_PROJ_COLS), D_MODEL ** -0.5),
        "w_gate_up": nrm(ks[8], (L, GLA_GATE_RANK, GLA_KEY_WIDTH), GLA_GATE_RANK ** -0.5),
        "b_gate": nrm(ks[9], (L, GLA_KEY_WIDTH), 0.1),
        "w_pool": nrm(ks[10], (L, POOL_GROUPS, POOL_GROUP_DIM, POOL_GROUP_DIM), POOL_GROUP_DIM ** -0.5),
        "pool_scale": 1.0 + nrm(ks[11], (L, POOL_WIDTH), 0.1),
        "gla_norm_g": 1.0 + nrm(ks[12], (L, GLA_WIDTH), 0.02),
        "w_out": nrm(ks[13], (L, MIX_WIDTH, D_MODEL), DEEPNORM_BETA * MIX_WIDTH ** -0.5),
        "ln2_g": 1.0 + nrm(ks[14], (L, D_MODEL), 0.02),
        "ln2_b": nrm(ks[15], (L, D_MODEL), 0.02),
        "ffn2_w_gate": nrm(ks[16], (L, D_MODEL, D_FF), D_MODEL ** -0.5),
        "ffn2_w_up": nrm(ks[17], (L, D_MODEL, D_FF), D_MODEL ** -0.5),
        "ffn2_w_down": nrm(ks[18], (L, D_FF, D_MODEL), DEEPNORM_BETA * D_FF ** -0.5),
        "ln3_g": 1.0 + nrm(ks[19], (L, D_MODEL), 0.02),
        "ln3_b": nrm(ks[20], (L, D_MODEL), 0.02),
    }


def reference(x, meta_tokens, ffn1_w_gate, ffn1_w_up, ffn1_w_down, ln1_g, ln1_b,
              w_in, w_gate_up, b_gate, w_pool, pool_scale, gla_norm_g, w_out,
              ln2_g, ln2_b, ffn2_w_gate, ffn2_w_up, ffn2_w_down, ln3_g, ln3_b):
    B_ = x.shape[0]
    meta = jnp.broadcast_to(meta_tokens[None].astype(x.dtype), (B_, N_META, D_MODEL))
    h = jnp.concatenate([meta, x], axis=1)
    a = DEEPNORM_ALPHA
    s0 = POOL_WIDTH
    s1 = s0 + GLA_KEY_WIDTH
    s2 = s1 + GLA_KEY_WIDTH
    s3 = s2 + GLA_WIDTH
    s4 = s3 + GLA_WIDTH
    for l in range(DEPTH):
        h = layer_norm(a * h + 0.5 * swiglu(h, ffn1_w_gate[l], ffn1_w_up[l], ffn1_w_down[l]),
                       ln1_g[l], ln1_b[l])
        z = h @ w_in[l]
        u_pool = z[..., :s0]
        q, k, v, r, g_lr = z[..., s0:s1], z[..., s1:s2], z[..., s2:s3], z[..., s3:s4], z[..., s4:]
        y_pool = pool_mixer(u_pool, w_pool[l], pool_scale[l])
        y_gla = gla_mixer(q, k, v, r, g_lr, w_gate_up[l], b_gate[l], gla_norm_g[l])
        y = jnp.concatenate([y_pool, y_gla], axis=-1) @ w_out[l]
        h = layer_norm(a * h + y, ln2_g[l], ln2_b[l])
        h = layer_norm(a * h + 0.5 * swiglu(h, ffn2_w_gate[l], ffn2_w_up[l], ffn2_w_down[l]),
                       ln3_g[l], ln3_b[l])
    return h[:, N_META:]
```

```cpp
#include <hip/hip_runtime.h>
#include <hip/hip_cooperative_groups.h>
#include <cstdio>
#include <cstdint>
namespace cg = cooperative_groups;
#ifndef ONE_LAUNCH
#define ONE_LAUNCH 1
#endif
namespace pg8 {
#define PG8_LAS __attribute__((address_space(3)))
typedef unsigned short bf16_t;
typedef short bf16x8 __attribute__((ext_vector_type(8)));
typedef float f32x4 __attribute__((ext_vector_type(4)));
typedef unsigned u32x4 __attribute__((ext_vector_type(4)));
constexpr int BM = 256, BK = 64, HALF = 128, HTB = HALF * BK * 2  , STAGE_BYTES = 8 * HTB, NXCD = 8, WGM = 8;

__host__ __device__ __forceinline__ int lds_byte(int r, int c) { const int st = (r >> 4) * 2 + (c >> 5), rr = r & 15, cc = c & 31, ob = rr * 64 + cc * 2; return st * 1024 + (ob ^ (((ob >> 9) & 1) << 5)); }
__host__ __device__ __forceinline__ void stage_rc(int b, int& R, int& C) { const int st = b / 1024, sb = b % 1024, swz = sb ^ (((sb >> 9) & 1) << 5); R = (st >> 1) * 16 + swz / 64; C = (st & 1) * 32 + (swz % 64) / 2; }
__host__ __device__ __forceinline__ int perm32(int rho) { const int n = rho >> 4, i = rho & 15; return 8 * (i >> 2) + 4 * n + (i & 3); }

struct Unit { int pm, pn; };
struct Gemm { const bf16_t* A; const bf16_t* Bt; int M, N, K; };

struct StaticOrder {
    int nM, nN, nwg, G, c;
    __host__ __device__ void init(int M, int N, int G_, int c_) { nM = M / BM; nN = N / BM; nwg = nM * nN; G = G_; c = c_; }
    __host__ __device__ bool next(int i, Unit& u) const {
        const long L = (long)i * G + c; if (L >= nwg) return false;
        int wgid = (int)L; { const int q = nwg / NXCD, r = nwg % NXCD, xcd = wgid % NXCD, off = wgid / NXCD; wgid = (xcd < r ? xcd * (q + 1) : r * (q + 1) + (xcd - r) * q) + off; }
        const int nig = WGM * nN, gid = wgid / nig, fm = gid * WGM, gsz = (nM - fm) < WGM ? (nM - fm) : WGM;
        u.pm = fm + ((wgid % nig) % gsz); u.pn = (wgid % nig) / gsz; return true;
    }
    __device__ __forceinline__ void a_ready(const Unit&) const {}
    __device__ __forceinline__ void done(const Unit&) const {}
};
__device__ __forceinline__ unsigned cvt_pk_bf16(float lo, float hi) { unsigned r; asm volatile("v_cvt_pk_bf16_f32 %0, %1, %2" : "=v"(r) : "v"(lo), "v"(hi)); return r; }
template <class Epi, class Sched, bool ALIGN_EPI = false, bool SP2 = false>
__device__ __forceinline__ void gemm_phase(PG8_LAS unsigned char* lds, const Gemm g, const Sched& S, const Epi& E) {
    const int tid = threadIdx.x, wid = __builtin_amdgcn_readfirstlane(tid >> 6), lane = tid & 63, wr = wid >> 2, wc = wid & 3, fr = lane & 15, fq = lane >> 4;
    const int K = g.K, nt = K / BK;
    unsigned voffA[2], voffB[2];
#pragma unroll
    for (int i = 0; i < 2; ++i) { int R, C; stage_rc(tid * 16 + i * 8192, R, C); const int Rb = Epi::PERM ? ((R & ~31) + perm32(R & 31)) : R;
        voffA[i] = (unsigned)(R * K + C) * 2u; voffB[i] = (unsigned)(Rb * K + C) * 2u; }
    const size_t kstep = (size_t)(BK * 2);
    const size_t hstep = (size_t)HALF * K * 2;
    const size_t tstep = 2 * hstep;
    const unsigned ldsw = (unsigned)wid * 1024u;
    const int aoff = lds_byte(wr * 64 + fr, fq * 8), boff = lds_byte(wc * 32 + fr, fq * 8);
#define PG8_SA(b, h) (((b) * 2 + (h)) * HTB)
#define PG8_SB(b, h) ((4 + (b) * 2 + (h)) * HTB)
#define PG8_STAGE(bufoff, gbase, voff) do { _Pragma("unroll") for (int _i = 0; _i < 2; ++_i) \
        __builtin_amdgcn_global_load_lds((const unsigned*)((const char*)(gbase) + (voff)[_i]), (PG8_LAS unsigned*)(lds + (bufoff) + ldsw + _i * 8192), 16, 0, 0); } while (0)
#define PG8_LDA(dst, b, h) do { _Pragma("unroll") for (int m = 0; m < 4; ++m) _Pragma("unroll") for (int k = 0; k < 2; ++k) dst[m][k] = *(const PG8_LAS bf16x8*)(lds + PG8_SA(b, h) + aoff + m * 2048 + k * 1024); } while (0)
#define PG8_LDB(dst, b, h) do { _Pragma("unroll") for (int n = 0; n < 2; ++n) _Pragma("unroll") for (int k = 0; k < 2; ++k) dst[n][k] = *(const PG8_LAS bf16x8*)(lds + PG8_SB(b, h) + boff + n * 2048 + k * 1024); } while (0)
#define PG8_MMA(ai, bj, At, Bt) do { __builtin_amdgcn_s_setprio(1); _Pragma("unroll") for (int m = 0; m < 4; ++m) _Pragma("unroll") for (int n = 0; n < 2; ++n) _Pragma("unroll") for (int k = 0; k < 2; ++k) \
        acc[ai][bj][m][n] = __builtin_amdgcn_mfma_f32_16x16x32_bf16(Bt[n][k], At[m][k], acc[ai][bj][m][n], 0, 0, 0); __builtin_amdgcn_s_setprio(0); } while (0)
#define PG8_WAIT_V(n) asm volatile("s_waitcnt vmcnt(" #n ")" ::: "memory")
#define PG8_WAIT_L(n) asm volatile("s_waitcnt lgkmcnt(" #n ")" ::: "memory")
#define PG8_BAR __builtin_amdgcn_s_barrier()
#define PG8_SCHED __builtin_amdgcn_sched_barrier(0)
    Unit cur, nxt; int ui = 0;
    if (!S.next(0, cur)) return;
    f32x4 acc[2][2][4][2];
#pragma unroll
    for (int a = 0; a < 2; ++a)
#pragma unroll
        for (int b = 0; b < 2; ++b)
#pragma unroll
            for (int m = 0; m < 4; ++m)
#pragma unroll
                for (int n = 0; n < 2; ++n) acc[a][b][m][n] = (f32x4){0.f, 0.f, 0.f, 0.f};
    bf16x8 At[4][2], B0[2][2], B1[2][2];
    const char* cA = (const char*)g.A + (size_t)cur.pm * tstep; const char* cB = (const char*)g.Bt + (size_t)cur.pn * tstep;
    S.a_ready(cur);
    if constexpr (SP2) {
        PG8_STAGE(PG8_SB(0, 0), cB, voffB); PG8_STAGE(PG8_SB(0, 1), cB + hstep, voffB); PG8_STAGE(PG8_SA(0, 0), cA, voffA); PG8_STAGE(PG8_SA(0, 1), cA + hstep, voffA);
        if (wr == 1) PG8_BAR;
        PG8_WAIT_V(2); PG8_BAR;
        PG8_STAGE(PG8_SB(1, 0), cB + kstep, voffB); PG8_STAGE(PG8_SA(1, 0), cA + kstep, voffA); PG8_STAGE(PG8_SB(1, 1), cB + hstep + kstep, voffB);
        PG8_WAIT_V(6); PG8_BAR;
    } else {
        PG8_STAGE(PG8_SB(0, 0), cB, voffB); PG8_STAGE(PG8_SA(0, 0), cA, voffA); PG8_STAGE(PG8_SB(0, 1), cB + hstep, voffB); PG8_STAGE(PG8_SA(0, 1), cA + hstep, voffA);
        if (wr == 1) PG8_BAR;
        PG8_WAIT_V(4); PG8_BAR;
        PG8_STAGE(PG8_SB(1, 0), cB + kstep, voffB); PG8_STAGE(PG8_SA(1, 0), cA + kstep, voffA); PG8_STAGE(PG8_SB(1, 1), cB + hstep + kstep, voffB);
        PG8_WAIT_V(6); PG8_BAR;
    }
    for (;;) {
        const bool has_next = S.next(ui + 1, nxt);
        const char* nA = has_next ? (const char*)g.A + (size_t)nxt.pm * tstep : cA; const char* nB = has_next ? (const char*)g.Bt + (size_t)nxt.pn * tstep : cB;
        for (int t = 0; t < nt; t += 2) {
            const bool last = (t == nt - 2);
            const char* a1 = cA + (size_t)(t + 1) * kstep;
            const char* a2 = last ? nA : cA + (size_t)(t + 2) * kstep; const char* b2 = last ? nB : cB + (size_t)(t + 2) * kstep;
            const char* a3 = a2 + kstep; const char* b3 = b2 + kstep;
            if (last && has_next) S.a_ready(nxt);
            if constexpr (SP2) {
            PG8_LDB(B0, 0, 0); PG8_LDB(B1, 0, 1); PG8_SCHED; PG8_LDA(At, 0, 0); PG8_STAGE(PG8_SA(1, 1), a1 + hstep, voffA);
            PG8_WAIT_V(8); PG8_WAIT_L(0); PG8_BAR; PG8_MMA(0, 0, At, B0); PG8_MMA(0, 1, At, B1); PG8_BAR; PG8_SCHED;
            PG8_LDA(At, 0, 1); PG8_STAGE(PG8_SB(0, 0), b2, voffB); PG8_STAGE(PG8_SB(0, 1), b2 + hstep, voffB); PG8_STAGE(PG8_SA(0, 0), a2, voffA);
            PG8_WAIT_V(8); PG8_WAIT_L(0); PG8_BAR; PG8_MMA(1, 0, At, B0); PG8_MMA(1, 1, At, B1); PG8_BAR; PG8_SCHED;
            PG8_LDB(B0, 1, 0); PG8_LDB(B1, 1, 1); PG8_SCHED; PG8_LDA(At, 1, 0); PG8_STAGE(PG8_SA(0, 1), a2 + hstep, voffA);
            PG8_WAIT_V(8); PG8_WAIT_L(0); PG8_BAR; PG8_MMA(0, 0, At, B0); PG8_MMA(0, 1, At, B1); PG8_BAR; PG8_SCHED;
            PG8_LDA(At, 1, 1); PG8_STAGE(PG8_SB(1, 0), b3, voffB); PG8_STAGE(PG8_SB(1, 1), b3 + hstep, voffB); PG8_STAGE(PG8_SA(1, 0), a3, voffA);
            PG8_WAIT_V(8); PG8_WAIT_L(0); PG8_BAR; PG8_MMA(1, 0, At, B0); PG8_MMA(1, 1, At, B1); PG8_BAR; PG8_SCHED;
            } else {
            PG8_LDB(B0, 0, 0); PG8_SCHED; PG8_LDA(At, 0, 0); PG8_STAGE(PG8_SA(1, 1), a1 + hstep, voffA);
            PG8_WAIT_L(8); PG8_BAR; PG8_WAIT_L(0); PG8_MMA(0, 0, At, B0); PG8_BAR; PG8_SCHED;
            PG8_LDB(B1, 0, 1); PG8_STAGE(PG8_SB(0, 0), b2, voffB);
            PG8_BAR; PG8_WAIT_L(0); PG8_MMA(0, 1, At, B1); PG8_BAR;
            PG8_LDA(At, 0, 1); PG8_STAGE(PG8_SA(0, 0), a2, voffA);
            PG8_BAR; PG8_WAIT_L(0); PG8_MMA(1, 0, At, B0); PG8_BAR; PG8_SCHED;
            PG8_STAGE(PG8_SB(0, 1), b2 + hstep, voffB);
            PG8_WAIT_V(6); PG8_BAR; PG8_MMA(1, 1, At, B1); PG8_BAR;
            PG8_LDB(B0, 1, 0); PG8_SCHED; PG8_LDA(At, 1, 0); PG8_STAGE(PG8_SA(0, 1), a2 + hstep, voffA);
            PG8_WAIT_L(8); PG8_BAR; PG8_WAIT_L(0); PG8_MMA(0, 0, At, B0); PG8_BAR; PG8_SCHED;
            PG8_LDB(B1, 1, 1); PG8_STAGE(PG8_SB(1, 0), b3, voffB);
            PG8_BAR; PG8_WAIT_L(0); PG8_MMA(0, 1, At, B1); PG8_BAR;
            PG8_LDA(At, 1, 1); PG8_STAGE(PG8_SA(1, 0), a3, voffA);
            PG8_BAR; PG8_WAIT_L(0); PG8_MMA(1, 0, At, B0); PG8_BAR; PG8_SCHED;
            PG8_STAGE(PG8_SB(1, 1), b3 + hstep, voffB);
            PG8_WAIT_V(6); PG8_BAR; PG8_MMA(1, 1, At, B1); PG8_BAR;
            }
        }
        if constexpr (ALIGN_EPI) { if (wr == 0) PG8_BAR; }
        if constexpr (!Epi::AFTER_DRAIN) { E(acc, cur, wr, wc, fr, fq); S.done(cur); }
        if (!has_next) break;
#pragma unroll
        for (int a = 0; a < 2; ++a)
#pragma unroll
            for (int b = 0; b < 2; ++b)
#pragma unroll
                for (int m = 0; m < 4; ++m)
#pragma unroll
                    for (int n = 0; n < 2; ++n) acc[a][b][m][n] = (f32x4){0.f, 0.f, 0.f, 0.f};
        cur = nxt; cA = nA; cB = nB; ++ui;
        if constexpr (ALIGN_EPI) { if (wr == 1) PG8_BAR; }
    }
    PG8_WAIT_V(0);
    if constexpr (!ALIGN_EPI) { if (wr == 0) PG8_BAR; }
    PG8_BAR;
    if constexpr (Epi::AFTER_DRAIN) { E.fused(acc, cur, wr, wc, fr, fq, lds, wid, lane); S.done(cur); }
#undef PG8_SA
#undef PG8_SB
#undef PG8_STAGE
#undef PG8_LDA
#undef PG8_LDB
#undef PG8_MMA
#undef PG8_WAIT_V
#undef PG8_WAIT_L
#undef PG8_BAR
#undef PG8_SCHED
}
}

#define LAS __attribute__((address_space(3)))
using pg8::bf16_t; using pg8::bf16x8; using pg8::f32x4; using pg8::u32x4; using pg8::Unit;
typedef float f32x16 __attribute__((ext_vector_type(16)));
typedef unsigned u32x2 __attribute__((ext_vector_type(2)));
typedef float f32x2_t __attribute__((ext_vector_type(2)));
typedef __bf16 bf16x2_t __attribute__((ext_vector_type(2)));
#define MFMA32(a, b, c) __builtin_amdgcn_mfma_f32_32x32x16_bf16((a), (b), (c), 0, 0, 0)
#define LDS_WAIT() asm volatile("s_waitcnt lgkmcnt(0)" ::: "memory")

__device__ __forceinline__ unsigned pk2(float lo, float hi) { f32x2_t v = {lo, hi}; bf16x2_t b = __builtin_convertvector(v, bf16x2_t); return __builtin_bit_cast(unsigned, b); }
__device__ __forceinline__ float bf_lo(unsigned u) { return __builtin_bit_cast(float, u << 16); }
__device__ __forceinline__ float bf_hi(unsigned u) { return __builtin_bit_cast(float, u & 0xffff0000u); }
__device__ __forceinline__ float fast_sigmoid(float x) { return __builtin_amdgcn_rcpf(1.f + __expf(-x)); }
__device__ __forceinline__ float silu(float x) { return x * fast_sigmoid(x); }
__device__ __forceinline__ float wave_sum(float v) {
#pragma unroll
    for (int o = 1; o < 64; o <<= 1) v += __shfl_xor(v, o);
    return v;
}

constexpr int DM = 1024, FF = 2816, NB = 2, SEQ = 8192, NMETA = 16, TSEQ = SEQ + NMETA;
constexpr int MMAIN = NB * SEQ;
constexpr int MTOT = MMAIN + NB * NMETA;
constexpr int MPAD = 65 * 256;
constexpr int NUP = 2 * FF;
constexpr int NIN = 2304;
constexpr int NINR = 2064;
constexpr int ZLD = 2048;
constexpr int ZC_Q = 512, ZC_K = 768, ZC_V = 1024, ZC_R = 1536;
constexpr int NCH = 129;
constexpr float ALPHA = 1.4142135623730951f;
constexpr float LN_EPS = 1e-5f, RMS_EPS = 1e-6f;

constexpr size_t MiB = 1u << 20;
constexpr size_t WS_HB = 0;
constexpr size_t WS_MIX = 33 * MiB;
constexpr size_t WS_Z = WS_MIX;
constexpr size_t WS_KVT = WS_MIX + 65 * MiB;
constexpr size_t WS_ST = WS_MIX + 98 * MiB;
constexpr size_t WS_DEC = WS_MIX + 115 * MiB;
constexpr size_t WS_G = WS_MIX;
constexpr size_t WS_W = 149 * MiB;
constexpr size_t WL_STRIDE = 40 * MiB;
constexpr size_t WO_W1A = 0, WO_W2A = 11 * MiB, WO_W1B = 33 * MiB / 2, WO_W2B = 55 * MiB / 2, WO_IN = 33 * MiB, WO_OUT = 75 * MiB / 2, WO_POOL = 79 * MiB / 2;
constexpr size_t WS_GL = 229 * MiB;
constexpr size_t WS_HM = 231 * MiB;
constexpr size_t WS_END = 232 * MiB;
static_assert((size_t)MPAD * 2816 * 2 <= 90 * MiB && (size_t)MPAD * 2048 * 2 <= 65 * MiB && (size_t)8 * NCH * 8192 * 4 <= 33 * MiB, "ws map");

constexpr int LDS_BYTES = 132096;
constexpr int NPHASES = 25;

struct Args { const float* in[21]; float* out; unsigned char* ws; int ph_lo, ph_hi; };

struct EpiAny {
    static constexpr bool PERM = true, AFTER_DRAIN = false;
    int mode; bf16_t* O; float* GL; const float* res_main; const float* res_meta; float* dst_main; float* dst_meta; float s;
    __device__ __forceinline__ void operator()(const f32x4 (&acc)[2][2][4][2], const Unit& u, int wr, int wc, int fr, int fq) const {
        if (mode == 0) {
            const int row0 = u.pm * 256 + wr * 64 + fr, col0 = u.pn * 128 + wc * 32 + 8 * fq;
#pragma unroll
            for (int ai = 0; ai < 2; ++ai)
#pragma unroll
                for (int m = 0; m < 4; ++m) {
                    const f32x4 g0 = acc[ai][0][m][0], g1 = acc[ai][0][m][1], u0 = acc[ai][1][m][0], u1 = acc[ai][1][m][1];
                    u32x4 w;
                    w.x = pk2(silu(g0[0]) * u0[0], silu(g0[1]) * u0[1]); w.y = pk2(silu(g0[2]) * u0[2], silu(g0[3]) * u0[3]);
                    w.z = pk2(silu(g1[0]) * u1[0], silu(g1[1]) * u1[1]); w.w = pk2(silu(g1[2]) * u1[2], silu(g1[3]) * u1[3]);
                    *(u32x4*)(O + (size_t)(row0 + ai * 128 + m * 16) * FF + col0) = w;
                }
        } else if (mode == 1) {
            const bool meta = u.pm >= 64;
            const float* res = meta ? res_meta : res_main; float* dst = meta ? dst_meta : dst_main;
            const int row0 = (meta ? 0 : u.pm * 256) + wr * 64 + fr, col0 = u.pn * 256 + wc * 32 + 8 * fq;
#pragma unroll
            for (int ai = 0; ai < 2; ++ai)
#pragma unroll
                for (int m = 0; m < 4; ++m) {
                    const size_t ro = (size_t)(row0 + ai * 128 + m * 16) * DM + col0;
#pragma unroll
                    for (int bj = 0; bj < 2; ++bj)
#pragma unroll
                        for (int n = 0; n < 2; ++n) {
                            const f32x4 r = *(const f32x4*)(res + ro + bj * 128 + 4 * n);
                            *(f32x4*)(dst + ro + bj * 128 + 4 * n) = r * ALPHA + acc[ai][bj][m][n] * s;
                        }
                }
        } else {
            const int row0 = u.pm * 256 + wr * 64 + fr;
            if (u.pn < 8) {
                const int col0 = u.pn * 256 + wc * 32 + 8 * fq;
#pragma unroll
                for (int ai = 0; ai < 2; ++ai)
#pragma unroll
                    for (int m = 0; m < 4; ++m)
#pragma unroll
                        for (int bj = 0; bj < 2; ++bj) {
                            const f32x4 v0 = acc[ai][bj][m][0], v1 = acc[ai][bj][m][1];
                            u32x4 w; w.x = pk2(v0[0], v0[1]); w.y = pk2(v0[2], v0[3]); w.z = pk2(v1[0], v1[1]); w.w = pk2(v1[2], v1[3]);
                            *(u32x4*)(O + (size_t)(row0 + ai * 128 + m * 16) * ZLD + col0 + bj * 128) = w;
                        }
            } else if (wc == 0 && fq < 2) {
#pragma unroll
                for (int ai = 0; ai < 2; ++ai)
#pragma unroll
                    for (int m = 0; m < 4; ++m) {
                        float* p = GL + (size_t)(row0 + ai * 128 + m * 16) * 16 + 8 * fq;
                        *(f32x4*)p = acc[ai][0][m][0]; *(f32x4*)(p + 4) = acc[ai][0][m][1];
                    }
            }
        }
    }
};

__device__ __forceinline__ void tr_item(const float* __restrict__ W, int N, bf16_t* WT, int ldt, int k0, int n0, int drow0, LAS float* scr, int lane) {
    const int nn = n0 + (lane & 31); const bool ok = nn < N;
#pragma unroll 8
    for (int i = 0; i < 32; ++i) { const int kk = 2 * i + (lane >> 5); scr[kk * 33 + (lane & 31)] = ok ? W[(size_t)(k0 + kk) * N + nn] : 0.f; }
    LDS_WAIT();
    const int c = lane & 7;
#pragma unroll
    for (int j = 0; j < 4; ++j) { const int n = (lane >> 3) + 8 * j; const LAS float* s = scr + (8 * c) * 33 + n;
        u32x4 o; o.x = pk2(s[0 * 33], s[1 * 33]); o.y = pk2(s[2 * 33], s[3 * 33]); o.z = pk2(s[4 * 33], s[5 * 33]); o.w = pk2(s[6 * 33], s[7 * 33]);
        *(u32x4*)(WT + (size_t)(drow0 + n) * ldt + k0 + 8 * c) = o; }
    LDS_WAIT();
}
constexpr int IT_FF = 16 * 88, IT_IN = 16 * 72, IT_OUT = 16 * 32, IT_POOL = 32, IT_LAYER = 6 * IT_FF + IT_IN + IT_OUT + IT_POOL;

__device__ __forceinline__ void prologue(const Args& a, LAS unsigned char* lds, int gw, int nw, int wid, int lane) {
    LAS float* scr = (LAS float*)(lds + wid * 8704);
    unsigned char* ws = a.ws;
    for (int item = gw; item < 2 * IT_LAYER; item += nw) {
        const int l = item / IT_LAYER; int r = item % IT_LAYER;
        unsigned char* wl = ws + WS_W + (size_t)l * WL_STRIDE;
        if (r < 6 * IT_FF) {
            const int which = r / IT_FF; r %= IT_FF;
            const int f = which / 3, t = which % 3;
            if (t < 2) {
                const float* W = a.in[(f ? 16 : 2) + t] + (size_t)l * DM * FF;
                const int kb = r / 88, nb = r % 88, n0 = 32 * nb;
                tr_item(W, FF, (bf16_t*)(wl + (f ? WO_W1B : WO_W1A)), DM, 64 * kb, n0, (n0 >> 7) * 256 + (n0 & 127) + 128 * t, scr, lane);
            } else {
                const float* W = a.in[f ? 18 : 4] + (size_t)l * FF * DM;
                const int kb = r / 32, nb = r % 32;
                tr_item(W, DM, (bf16_t*)(wl + (f ? WO_W2B : WO_W2A)), FF, 64 * kb, 32 * nb, 32 * nb, scr, lane);
            }
            continue;
        }
        r -= 6 * IT_FF;
        if (r < IT_IN) { const int kb = r / 72, nb = r % 72; tr_item(a.in[7] + (size_t)l * DM * NINR, NINR, (bf16_t*)(wl + WO_IN), DM, 64 * kb, 32 * nb, 32 * nb, scr, lane); continue; }
        r -= IT_IN;
        if (r < IT_OUT) { const int kb = r / 32, nb = r % 32; tr_item(a.in[13] + (size_t)l * DM * DM, DM, (bf16_t*)(wl + WO_OUT), DM, 64 * kb, 32 * nb, 32 * nb, scr, lane); continue; }
        r -= IT_OUT;
        { const int g = r >> 3, kb = (r >> 2) & 1, nb = r & 3;
          tr_item(a.in[10] + ((size_t)l * 4 + g) * 128 * 128, 128, (bf16_t*)(wl + WO_POOL), 128, 64 * kb, 32 * nb, g * 128 + 32 * nb, scr, lane); }
    }
    bf16_t* HB = (bf16_t*)(ws + WS_HB); float* HM = (float*)(ws + WS_HM);
    for (int r = gw; r < MTOT; r += nw) {
        const float* src = r < MMAIN ? a.in[0] + (size_t)r * DM : a.in[1] + (size_t)((r - MMAIN) & 15) * DM;
#pragma unroll
        for (int j = 0; j < 4; ++j) {
            const f32x4 v = *(const f32x4*)(src + 4 * lane + 256 * j);
            u32x2 o; o.x = pk2(v[0], v[1]); o.y = pk2(v[2], v[3]);
            *(u32x2*)(HB + (size_t)r * DM + 4 * lane + 256 * j) = o;
            if (r >= MMAIN) *(f32x4*)(HM + (size_t)(r - MMAIN) * DM + 4 * lane + 256 * j) = v;
        }
    }
}

__device__ __forceinline__ void ln_phase(float* Hmain, float* HM, bf16_t* HB, const float* __restrict__ g, const float* __restrict__ b, int gw, int nw, int lane) {
    f32x4 gv[4], bv[4];
#pragma unroll
    for (int j = 0; j < 4; ++j) { gv[j] = *(const f32x4*)(g + 4 * lane + 256 * j); bv[j] = *(const f32x4*)(b + 4 * lane + 256 * j); }
    for (int r = gw; r < MTOT; r += nw) {
        float* p = r < MMAIN ? Hmain + (size_t)r * DM : HM + (size_t)(r - MMAIN) * DM;
        f32x4 v[4]; float s = 0.f;
#pragma unroll
        for (int j = 0; j < 4; ++j) { v[j] = *(const f32x4*)(p + 4 * lane + 256 * j); s += (v[j][0] + v[j][1]) + (v[j][2] + v[j][3]); }
        const float mean = wave_sum(s) * (1.f / DM); float s2 = 0.f;
#pragma unroll
        for (int j = 0; j < 4; ++j) { v[j] = v[j] - mean; s2 += (v[j][0] * v[j][0] + v[j][1] * v[j][1]) + (v[j][2] * v[j][2] + v[j][3] * v[j][3]); }
        const float rstd = rsqrtf(wave_sum(s2) * (1.f / DM) + LN_EPS);
#pragma unroll
        for (int j = 0; j < 4; ++j) {
            const f32x4 y = v[j] * rstd * gv[j] + bv[j];
            *(f32x4*)(p + 4 * lane + 256 * j) = y;
            u32x2 o; o.x = pk2(y[0], y[1]); o.y = pk2(y[2], y[3]);
            *(u32x2*)(HB + (size_t)r * DM + 4 * lane + 256 * j) = o;
        }
    }
}

__device__ __forceinline__ int chunk_row(int b, int c, int i) { return c == 0 ? (i < 48 ? -1 : MMAIN + b * 16 + (i - 48)) : b * SEQ + (c - 1) * 64 + i; }
__device__ __forceinline__ int seq_row(int b, int s) { return s < NMETA ? MMAIN + b * 16 + s : b * SEQ + s - NMETA; }

__device__ __forceinline__ void gate_cumsum(const float* __restrict__ GL, const float* __restrict__ Wg, const float* __restrict__ bg, int row, int h, int w, int lane, float (&bc)[8]) {
    f32x4 g4[4];
#pragma unroll
    for (int j = 0; j < 4; ++j) g4[j] = row >= 0 ? *(const f32x4*)(GL + (size_t)row * 16 + 4 * j) : (f32x4){0.f, 0.f, 0.f, 0.f};
    const float* wp = Wg + h * 64 + 8 * w; const float* bp = bg + h * 64 + 8 * w;
#pragma unroll
    for (int i = 0; i < 8; ++i) {
        float x = bp[i];
#pragma unroll
        for (int r = 0; r < 16; ++r) x += g4[r >> 2][r & 3] * wp[r * 256 + i];
        float la = (fminf(x, 0.f) - __logf(1.f + __expf(-fabsf(x)))) * (1.f / 16.f);
        if (row < 0) la = 0.f;
#pragma unroll
        for (int off = 1; off < 64; off <<= 1) { const float t = __shfl_up(la, off); if (lane >= off) la += t; }
        bc[i] = la;
    }
}

constexpr int L_QE = 0, L_KE = 9216, L_VT = 18432, L_RED = 36864, LROW = 72;

__device__ __forceinline__ void stage_vT(const bf16_t* __restrict__ Z, int row, int h, int w, int lane, LAS unsigned char* lds) {
    u32x4 v0 = {0, 0, 0, 0}, v1 = {0, 0, 0, 0};
    if (row >= 0) { const bf16_t* p = Z + (size_t)row * ZLD + ZC_V + h * 128 + 16 * w; v0 = *(const u32x4*)p; v1 = *(const u32x4*)(p + 8); }
    LAS bf16_t* vt = (LAS bf16_t*)(lds + L_VT) + (16 * w) * LROW + lane;
#pragma unroll
    for (int i = 0; i < 4; ++i) { vt[(2 * i) * LROW] = (bf16_t)(v0[i] & 0xffffu); vt[(2 * i + 1) * LROW] = (bf16_t)(v0[i] >> 16);
                                  vt[(8 + 2 * i) * LROW] = (bf16_t)(v1[i] & 0xffffu); vt[(9 + 2 * i) * LROW] = (bf16_t)(v1[i] >> 16); }
}

__device__ __forceinline__ void mixa_phase(const Args& a, int l, LAS unsigned char* lds, int wid, int lane) {
    unsigned char* ws = a.ws;
    const bf16_t* Z = (const bf16_t*)(ws + WS_Z); const float* GL = (const float*)(ws + WS_GL);
    float* KVT = (float*)(ws + WS_KVT); float* DEC = (float*)(ws + WS_DEC);
    const float* Wg = a.in[8] + (size_t)l * 16 * 256; const float* bg = a.in[9] + (size_t)l * 256;
    const int l31 = lane & 31, hi = lane >> 5;
    for (int u = blockIdx.x; u < 2 * 128 * 4; u += gridDim.x) {
        const int h = u & 3, c = (u >> 2) & 127, b = u >> 9, bh = b * 4 + h;
        const int row = chunk_row(b, c, lane);
        float bc[8]; gate_cumsum(GL, Wg, bg, row, h, wid, lane, bc);
        u32x4 kv = {0, 0, 0, 0};
        if (row >= 0) kv = *(const u32x4*)(Z + (size_t)row * ZLD + ZC_K + h * 64 + 8 * wid);
        LAS bf16_t* kdt = (LAS bf16_t*)(lds + L_KE) + (8 * wid) * LROW + lane;
#pragma unroll
        for (int i = 0; i < 8; ++i) {
            const float bl = __shfl(bc[i], 63);
            const float kf = (i & 1) ? bf_hi(kv[i >> 1]) : bf_lo(kv[i >> 1]);
            kdt[i * LROW] = (bf16_t)(pk2(kf * __expf(bl - bc[i]), 0.f) & 0xffffu);
            if (lane == 63) DEC[(size_t)(bh * NCH + c) * 64 + 8 * wid + i] = __expf(bl);
        }
        stage_vT(Z, row, h, wid, lane, lds);
        __syncthreads();
        const int eb = wid >> 1, db = wid & 1;
        f32x16 acc = {0.f, 0.f, 0.f, 0.f, 0.f, 0.f, 0.f, 0.f, 0.f, 0.f, 0.f, 0.f, 0.f, 0.f, 0.f, 0.f};
#pragma unroll
        for (int s = 0; s < 4; ++s) {
            const bf16x8 A = *(const LAS bf16x8*)(lds + L_VT + ((eb * 32 + l31) * LROW + 16 * s + 8 * hi) * 2);
            const bf16x8 B = *(const LAS bf16x8*)(lds + L_KE + ((db * 32 + l31) * LROW + 16 * s + 8 * hi) * 2);
            acc = MFMA32(A, B, acc);
        }
        float* o = KVT + ((size_t)(bh * NCH + c) * 128 + eb * 32 + 4 * hi) * 64 + db * 32 + l31;
#pragma unroll
        for (int r = 0; r < 16; ++r) o[((r & 3) + 8 * (r >> 2)) * 64] = acc[r];
        __syncthreads();
    }
}

__device__ __forceinline__ void mixb_phase(const Args& a, int l, int wid, int lane) {
    unsigned char* ws = a.ws;
    const int G = gridDim.x;
    {
        const float* __restrict__ KVT = (const float*)(ws + WS_KVT); const float* __restrict__ DEC = (const float*)(ws + WS_DEC);
        bf16_t* __restrict__ ST = (bf16_t*)(ws + WS_ST);
        for (int gw = wid * G + blockIdx.x; gw < 1024; gw += 8 * G) {
            const int rec = gw * 64 + lane, bh = rec >> 13, ed = rec & 8191, d = ed & 63;
            const float* kp = KVT + (size_t)bh * NCH * 8192 + ed; const float* dp = DEC + (size_t)bh * NCH * 64 + d; bf16_t* sp = ST + (size_t)bh * NCH * 8192 + 8192 + ed;
            float S = 0.f;
#pragma unroll 16
            for (int c = 0; c < 128; ++c) { S = S * dp[(size_t)c * 64] + kp[(size_t)c * 8192]; sp[(size_t)c * 8192] = (bf16_t)(pk2(S, 0.f) & 0xffffu); }
        }
    }
    {
        const bf16_t* __restrict__ Z = (const bf16_t*)(ws + WS_Z); bf16_t* Y = (bf16_t*)(ws + WS_HB);
        const bf16_t* __restrict__ WPT = (const bf16_t*)(ws + WS_W + (size_t)l * WL_STRIDE + WO_POOL);
        const float* __restrict__ psc = a.in[11] + (size_t)l * 512;
        const int l31 = lane & 31, hi = lane >> 5;
        for (int pu = (7 - wid) * G + blockIdx.x; pu < 2 * 257 * 4; pu += 8 * G) {
            const int g = pu & 3, blk = (pu >> 2) % 257, b = (pu >> 2) / 257;
            const int pos = 32 * blk + l31; const bool valid = pos < TSEQ;
            const int w = 2 << g; const float inv = 1.f / (float)min(pos + 1, w);
            f32x16 acc[4];
#pragma unroll
            for (int nb = 0; nb < 4; ++nb) acc[nb] = (f32x16){0.f, 0.f, 0.f, 0.f, 0.f, 0.f, 0.f, 0.f, 0.f, 0.f, 0.f, 0.f, 0.f, 0.f, 0.f, 0.f};
            for (int ks = 0; ks < 8; ++ks) {
                const int c0 = g * 128 + 16 * ks + 8 * hi;
                float sum[8], self[8];
#pragma unroll
                for (int i = 0; i < 8; ++i) { sum[i] = 0.f; self[i] = 0.f; }
                for (int j = 0; j < w; ++j) {
                    const int ps = pos - j;
                    if (valid && ps >= 0) {
                        const u32x4 v = *(const u32x4*)(Z + (size_t)seq_row(b, ps) * ZLD + c0);
#pragma unroll
                        for (int i = 0; i < 4; ++i) { sum[2 * i] += bf_lo(v[i]); sum[2 * i + 1] += bf_hi(v[i]); }
                        if (j == 0) {
#pragma unroll
                            for (int i = 0; i < 4; ++i) { self[2 * i] = bf_lo(v[i]); self[2 * i + 1] = bf_hi(v[i]); }
                        }
                    }
                }
                u32x4 pa;
#pragma unroll
                for (int i = 0; i < 4; ++i) pa[i] = pk2(sum[2 * i] * inv - self[2 * i], sum[2 * i + 1] * inv - self[2 * i + 1]);
                const bf16x8 A = __builtin_bit_cast(bf16x8, pa);
#pragma unroll
                for (int nb = 0; nb < 4; ++nb) {
                    const bf16x8 B = *(const bf16x8*)(WPT + (size_t)(g * 128 + nb * 32 + l31) * 128 + 16 * ks + 8 * hi);
                    acc[nb] = MFMA32(A, B, acc[nb]);
                }
            }
#pragma unroll
            for (int r = 0; r < 16; ++r) {
                const int p2 = 32 * blk + (r & 3) + 8 * (r >> 2) + 4 * hi;
                if (p2 < TSEQ) {
                    bf16_t* yo = Y + (size_t)seq_row(b, p2) * DM + g * 128 + l31;
#pragma unroll
                    for (int nb = 0; nb < 4; ++nb) yo[nb * 32] = (bf16_t)(pk2(acc[nb][r] * psc[g * 128 + nb * 32 + l31], 0.f) & 0xffffu);
                }
            }
        }
    }
}

__device__ __forceinline__ void mixc_phase(const Args& a, int l, LAS unsigned char* lds, int wid, int lane) {
    unsigned char* ws = a.ws;
    const bf16_t* Z = (const bf16_t*)(ws + WS_Z); const float* GL = (const float*)(ws + WS_GL);
    const bf16_t* ST = (const bf16_t*)(ws + WS_ST); bf16_t* Y = (bf16_t*)(ws + WS_HB);
    const float* Wg = a.in[8] + (size_t)l * 16 * 256; const float* bg = a.in[9] + (size_t)l * 256;
    const float* gn = a.in[12] + (size_t)l * 512;
    const int l31 = lane & 31, hi = lane >> 5;
    for (int u = blockIdx.x; u < 2 * NCH * 4; u += gridDim.x) {
        const int h = u & 3, c = (u >> 2) % NCH, b = (u >> 2) / NCH, bh = b * 4 + h;
        const int row = chunk_row(b, c, lane);
        float bc[8]; gate_cumsum(GL, Wg, bg, row, h, wid, lane, bc);
        u32x4 qv = {0, 0, 0, 0}, kv = {0, 0, 0, 0};
        if (row >= 0) { const bf16_t* p = Z + (size_t)row * ZLD + h * 64 + 8 * wid; qv = *(const u32x4*)(p + ZC_Q); kv = *(const u32x4*)(p + ZC_K); }
        u32x4 qo, ko;
#pragma unroll
        for (int i = 0; i < 4; ++i) {
            const float e0 = __expf(bc[2 * i]), e1 = __expf(bc[2 * i + 1]), n0 = __expf(-bc[2 * i]), n1 = __expf(-bc[2 * i + 1]);
            qo[i] = pk2(bf_lo(qv[i]) * e0 * 0.125f, bf_hi(qv[i]) * e1 * 0.125f);
            ko[i] = pk2(bf_lo(kv[i]) * n0, bf_hi(kv[i]) * n1);
        }
        *(LAS u32x4*)(lds + L_QE + (lane * LROW + 8 * wid) * 2) = qo;
        *(LAS u32x4*)(lds + L_KE + (lane * LROW + 8 * wid) * 2) = ko;
        stage_vT(Z, row, h, wid, lane, lds);
        __syncthreads();
        const int eb = wid & 3, ib = wid >> 2;
        f32x16 acc = {0.f, 0.f, 0.f, 0.f, 0.f, 0.f, 0.f, 0.f, 0.f, 0.f, 0.f, 0.f, 0.f, 0.f, 0.f, 0.f};
        if (c > 0) {
            const bf16_t* sp = ST + ((size_t)(bh * NCH + c) * 128 + eb * 32 + l31) * 64 + 8 * hi;
#pragma unroll
            for (int s = 0; s < 4; ++s) {
                const bf16x8 A = *(const bf16x8*)(sp + 16 * s);
                const bf16x8 B = *(const LAS bf16x8*)(lds + L_QE + ((ib * 32 + l31) * LROW + 16 * s + 8 * hi) * 2);
                acc = MFMA32(A, B, acc);
            }
        }
        for (int jb = 0; jb <= ib; ++jb) {
            f32x16 p = {0.f, 0.f, 0.f, 0.f, 0.f, 0.f, 0.f, 0.f, 0.f, 0.f, 0.f, 0.f, 0.f, 0.f, 0.f, 0.f};
#pragma unroll
            for (int s = 0; s < 4; ++s) {
                const bf16x8 A = *(const LAS bf16x8*)(lds + L_KE + ((jb * 32 + l31) * LROW + 16 * s + 8 * hi) * 2);
                const bf16x8 B = *(const LAS bf16x8*)(lds + L_QE + ((ib * 32 + l31) * LROW + 16 * s + 8 * hi) * 2);
                p = MFMA32(A, B, p);
            }
            if (jb == ib) {
#pragma unroll
                for (int r = 0; r < 16; ++r) if ((r & 3) + 8 * (r >> 2) + 4 * hi > l31) p[r] = 0.f;
            }
#pragma unroll
            for (int s2 = 0; s2 < 2; ++s2) {
                u32x4 pb;
#pragma unroll
                for (int i = 0; i < 4; ++i) pb[i] = pk2(p[8 * s2 + 2 * i], p[8 * s2 + 2 * i + 1]);
                const LAS unsigned char* vp = lds + L_VT + ((eb * 32 + l31) * LROW + jb * 32 + 16 * s2 + 4 * hi) * 2;
                const u32x2 a0 = *(const LAS u32x2*)vp, a1 = *(const LAS u32x2*)(vp + 16);
                const u32x4 pa = {a0.x, a0.y, a1.x, a1.y};
                acc = MFMA32(__builtin_bit_cast(bf16x8, pa), __builtin_bit_cast(bf16x8, pb), acc);
            }
        }
        float ss = 0.f;
#pragma unroll
        for (int r = 0; r < 16; ++r) ss += acc[r] * acc[r];
        ss += __shfl_xor(ss, 32);
        LAS float* red = (LAS float*)(lds + L_RED);
        if (hi == 0) red[eb * 64 + ib * 32 + l31] = ss;
        __syncthreads();
        const int ti = ib * 32 + l31;
        const float tot = (red[ti] + red[64 + ti]) + (red[128 + ti] + red[192 + ti]);
        const float rstd = rsqrtf(tot * (1.f / 128.f) + RMS_EPS);
        const int orow = chunk_row(b, c, ti);
        if (orow >= 0) {
#pragma unroll
            for (int rg = 0; rg < 4; ++rg) {
                const int e0 = h * 128 + eb * 32 + 8 * rg + 4 * hi;
                const u32x2 rv = *(const u32x2*)(Z + (size_t)orow * ZLD + ZC_R + e0);
                const f32x4 gv = *(const f32x4*)(gn + e0);
                u32x2 o;
                o.x = pk2(acc[4 * rg] * rstd * gv[0] * silu(bf_lo(rv.x)), acc[4 * rg + 1] * rstd * gv[1] * silu(bf_hi(rv.x)));
                o.y = pk2(acc[4 * rg + 2] * rstd * gv[2] * silu(bf_lo(rv.y)), acc[4 * rg + 3] * rstd * gv[3] * silu(bf_hi(rv.y)));
                *(u32x2*)(Y + (size_t)orow * DM + 512 + e0) = o;
            }
        }
        __syncthreads();
    }
}

__global__ void __launch_bounds__(512, 2) fwd_kernel(Args a) {
    extern __shared__ __attribute__((aligned(16))) unsigned char lds_raw[];
    LAS unsigned char* lds = (LAS unsigned char*)lds_raw;
    for (int ph = a.ph_lo; ph < a.ph_hi; ++ph) {
        int tid = threadIdx.x; asm volatile("" : "+v"(tid));
        const int lane = tid & 63, wid = __builtin_amdgcn_readfirstlane(tid >> 6);
        const int G = gridDim.x, gw = blockIdx.x * 8 + wid, nw = G * 8;
        unsigned char* ws = a.ws; asm volatile("" : "+s"(ws));
        bf16_t* HB = (bf16_t*)(ws + WS_HB); float* HM = (float*)(ws + WS_HM);
        if (ph == 0) {
            prologue(a, lds, gw, nw, wid, lane);
        } else {
            const int q = ph - 1, l = q / 12, p = q % 12;
            unsigned char* wl = ws + WS_W + (size_t)l * WL_STRIDE;
            if (p == 0 || p == 9 || p == 1 || p == 7 || p == 10 || p == 3) {
                const int mode = (p == 0 || p == 9) ? 0 : (p == 3 ? 2 : 1);
                const bool outp = (p == 7);
                const bf16_t* A = (mode == 1 && !outp) ? (const bf16_t*)(ws + WS_G) : HB;
                const size_t wo = p == 0 ? WO_W1A : p == 9 ? WO_W1B : p == 1 ? WO_W2A : p == 10 ? WO_W2B : p == 7 ? WO_OUT : WO_IN;
                const int N = mode == 0 ? NUP : (mode == 2 ? NIN : DM), K = (mode == 1 && !outp) ? FF : DM;
                pg8::Gemm g{A, (const bf16_t*)(wl + wo), MPAD, N, K};
                pg8::StaticOrder S; S.init(MPAD, N, G, (int)blockIdx.x);
                EpiAny E{mode, (bf16_t*)(ws + (mode == 0 ? WS_G : WS_Z)), (float*)(ws + WS_GL), (l == 0 && p == 1) ? a.in[0] : a.out, HM, a.out, HM, outp ? 1.0f : 0.5f};
                pg8::gemm_phase<EpiAny, pg8::StaticOrder, true, true>(lds, g, S, E);
            } else if (p == 2 || p == 8 || p == 11) {
                const int gi = p == 2 ? 5 : (p == 8 ? 14 : 19);
                ln_phase(a.out, HM, HB, a.in[gi] + (size_t)l * DM, a.in[gi + 1] + (size_t)l * DM, gw, nw, lane);
            } else if (p == 4) { mixa_phase(a, l, lds, wid, lane);
            } else if (p == 5) { mixb_phase(a, l, wid, lane);
            } else { mixc_phase(a, l, lds, wid, lane); }
        }
        if (ph + 1 < a.ph_hi) cg::this_grid().sync();
    }
}

extern "C" void kernel_launch(void* const* d_in, const int* in_sizes, int n_in, void* d_out, int out_size, void* d_ws, size_t ws_size, hipStream_t stream) {
    static int grid = 0;
    if (grid == 0) {
        if (n_in != 21 || out_size != MMAIN * DM || ws_size < WS_END) { fprintf(stderr, "kernel_launch: unexpected shapes (n_in %d, out %d, ws %zu)\n", n_in, out_size, ws_size); grid = -1; return; }
        int dev = 0, cus = 0, per_cu = 0;
        if (hipGetDevice(&dev) != hipSuccess || hipDeviceGetAttribute(&cus, hipDeviceAttributeMultiprocessorCount, dev) != hipSuccess) { grid = -1; return; }
        if (hipFuncSetAttribute((const void*)fwd_kernel, hipFuncAttributeMaxDynamicSharedMemorySize, LDS_BYTES) != hipSuccess) { fprintf(stderr, "kernel_launch: hipFuncSetAttribute failed\n"); grid = -1; return; }
        if (hipOccupancyMaxActiveBlocksPerMultiprocessor(&per_cu, (const void*)fwd_kernel, 512, LDS_BYTES) != hipSuccess || per_cu < 1) { fprintf(stderr, "kernel_launch: occupancy query gave %d\n", per_cu); per_cu = 1; }
        (void)hipGetLastError();
        grid = cus * per_cu;
    }
    if (grid < 0) return;
    Args a{};
    for (int i = 0; i < 21; ++i) a.in[i] = (const float*)d_in[i];
    a.out = (float*)d_out; a.ws = (unsigned char*)d_ws;
#if ONE_LAUNCH
    a.ph_lo = 0; a.ph_hi = NPHASES;
    void* args[] = {&a};
    hipError_t e = hipLaunchCooperativeKernel((const void*)fwd_kernel, dim3(grid), dim3(512), args, LDS_BYTES, stream);
    if (e != hipSuccess) fprintf(stderr, "kernel_launch: cooperative launch failed: %s (grid %d)\n", hipGetErrorString(e), grid);
#else
    for (int ph = 0; ph < NPHASES; ++ph) {
        a.ph_lo = ph; a.ph_hi = ph + 1;
        hipLaunchKernelGGL(fwd_kernel, dim3(grid), dim3(512), LDS_BYTES, stream, a);
    }
#endif
}
```

```cpp
#include <hip/hip_runtime.h>
#include <hip/hip_cooperative_groups.h>
#include <cstdio>
#include <cstdint>
namespace cg = cooperative_groups;
#ifndef PROBE_A
#define PROBE_A 1
#define PROBE_B 1
#define PROBE_C 1
#define PROBE_P 1
#endif
#ifndef ONE_LAUNCH
#define ONE_LAUNCH 1
#endif
namespace pg8 {
#define PG8_LAS __attribute__((address_space(3)))
typedef unsigned short bf16_t;
typedef short bf16x8 __attribute__((ext_vector_type(8)));
typedef float f32x4 __attribute__((ext_vector_type(4)));
typedef unsigned u32x4 __attribute__((ext_vector_type(4)));
constexpr int BM = 256, BK = 64, HALF = 128, HTB = HALF * BK * 2  , STAGE_BYTES = 8 * HTB, NXCD = 8, WGM = 8;

__host__ __device__ __forceinline__ int lds_byte(int r, int c) { const int st = (r >> 4) * 2 + (c >> 5), rr = r & 15, cc = c & 31, ob = rr * 64 + cc * 2; return st * 1024 + (ob ^ (((ob >> 9) & 1) << 5)); }
__host__ __device__ __forceinline__ void stage_rc(int b, int& R, int& C) { const int st = b / 1024, sb = b % 1024, swz = sb ^ (((sb >> 9) & 1) << 5); R = (st >> 1) * 16 + swz / 64; C = (st & 1) * 32 + (swz % 64) / 2; }
__host__ __device__ __forceinline__ int perm32(int rho) { const int n = rho >> 4, i = rho & 15; return 8 * (i >> 2) + 4 * n + (i & 3); }

struct Unit { int pm, pn; };
struct Gemm { const bf16_t* A; const bf16_t* Bt; int M, N, K; };

struct StaticOrder {
    int nM, nN, nwg, G, c;
    __host__ __device__ void init(int M, int N, int G_, int c_) { nM = M / BM; nN = N / BM; nwg = nM * nN; G = G_; c = c_; }
    __host__ __device__ bool next(int i, Unit& u) const {
        const long L = (long)i * G + c; if (L >= nwg) return false;
        int wgid = (int)L; { const int q = nwg / NXCD, r = nwg % NXCD, xcd = wgid % NXCD, off = wgid / NXCD; wgid = (xcd < r ? xcd * (q + 1) : r * (q + 1) + (xcd - r) * q) + off; }
        const int nig = WGM * nN, gid = wgid / nig, fm = gid * WGM, gsz = (nM - fm) < WGM ? (nM - fm) : WGM;
        u.pm = fm + ((wgid % nig) % gsz); u.pn = (wgid % nig) / gsz; return true;
    }
    __device__ __forceinline__ void a_ready(const Unit&) const {}
    __device__ __forceinline__ void done(const Unit&) const {}
};
__device__ __forceinline__ unsigned cvt_pk_bf16(float lo, float hi) { unsigned r; asm volatile("v_cvt_pk_bf16_f32 %0, %1, %2" : "=v"(r) : "v"(lo), "v"(hi)); return r; }
template <class Epi, class Sched, bool ALIGN_EPI = false, bool SP2 = false>
__device__ __forceinline__ void gemm_phase(PG8_LAS unsigned char* lds, const Gemm g, const Sched& S, const Epi& E) {
    const int tid = threadIdx.x, wid = __builtin_amdgcn_readfirstlane(tid >> 6), lane = tid & 63, wr = wid >> 2, wc = wid & 3, fr = lane & 15, fq = lane >> 4;
    const int K = g.K, nt = K / BK;
    unsigned voffA[2], voffB[2];
#pragma unroll
    for (int i = 0; i < 2; ++i) { int R, C; stage_rc(tid * 16 + i * 8192, R, C); const int Rb = Epi::PERM ? ((R & ~31) + perm32(R & 31)) : R;
        voffA[i] = (unsigned)(R * K + C) * 2u; voffB[i] = (unsigned)(Rb * K + C) * 2u; }
    const size_t kstep = (size_t)(BK * 2);
    const size_t hstep = (size_t)HALF * K * 2;
    const size_t tstep = 2 * hstep;
    const unsigned ldsw = (unsigned)wid * 1024u;
    const int aoff = lds_byte(wr * 64 + fr, fq * 8), boff = lds_byte(wc * 32 + fr, fq * 8);
#define PG8_SA(b, h) (((b) * 2 + (h)) * HTB)
#define PG8_SB(b, h) ((4 + (b) * 2 + (h)) * HTB)
#define PG8_STAGE(bufoff, gbase, voff) do { _Pragma("unroll") for (int _i = 0; _i < 2; ++_i) \
        __builtin_amdgcn_global_load_lds((const unsigned*)((const char*)(gbase) + (voff)[_i]), (PG8_LAS unsigned*)(lds + (bufoff) + ldsw + _i * 8192), 16, 0, 0); } while (0)
#define PG8_LDA(dst, b, h) do { _Pragma("unroll") for (int m = 0; m < 4; ++m) _Pragma("unroll") for (int k = 0; k < 2; ++k) dst[m][k] = *(const PG8_LAS bf16x8*)(lds + PG8_SA(b, h) + aoff + m * 2048 + k * 1024); } while (0)
#define PG8_LDB(dst, b, h) do { _Pragma("unroll") for (int n = 0; n < 2; ++n) _Pragma("unroll") for (int k = 0; k < 2; ++k) dst[n][k] = *(const PG8_LAS bf16x8*)(lds + PG8_SB(b, h) + boff + n * 2048 + k * 1024); } while (0)
#define PG8_MMA(ai, bj, At, Bt) do { __builtin_amdgcn_s_setprio(1); _Pragma("unroll") for (int m = 0; m < 4; ++m) _Pragma("unroll") for (int n = 0; n < 2; ++n) _Pragma("unroll") for (int k = 0; k < 2; ++k) \
        acc[ai][bj][m][n] = __builtin_amdgcn_mfma_f32_16x16x32_bf16(Bt[n][k], At[m][k], acc[ai][bj][m][n], 0, 0, 0); __builtin_amdgcn_s_setprio(0); } while (0)
#define PG8_WAIT_V(n) asm volatile("s_waitcnt vmcnt(" #n ")" ::: "memory")
#define PG8_WAIT_L(n) asm volatile("s_waitcnt lgkmcnt(" #n ")" ::: "memory")
#define PG8_BAR __builtin_amdgcn_s_barrier()
#define PG8_SCHED __builtin_amdgcn_sched_barrier(0)
    Unit cur, nxt; int ui = 0;
    if (!S.next(0, cur)) return;
    f32x4 acc[2][2][4][2];
#pragma unroll
    for (int a = 0; a < 2; ++a)
#pragma unroll
        for (int b = 0; b < 2; ++b)
#pragma unroll
            for (int m = 0; m < 4; ++m)
#pragma unroll
                for (int n = 0; n < 2; ++n) acc[a][b][m][n] = (f32x4){0.f, 0.f, 0.f, 0.f};
    bf16x8 At[4][2], B0[2][2], B1[2][2];
    const char* cA = (const char*)g.A + (size_t)cur.pm * tstep; const char* cB = (const char*)g.Bt + (size_t)cur.pn * tstep;
    S.a_ready(cur);
    if constexpr (SP2) {
        PG8_STAGE(PG8_SB(0, 0), cB, voffB); PG8_STAGE(PG8_SB(0, 1), cB + hstep, voffB); PG8_STAGE(PG8_SA(0, 0), cA, voffA); PG8_STAGE(PG8_SA(0, 1), cA + hstep, voffA);
        if (wr == 1) PG8_BAR;
        PG8_WAIT_V(2); PG8_BAR;
        PG8_STAGE(PG8_SB(1, 0), cB + kstep, voffB); PG8_STAGE(PG8_SA(1, 0), cA + kstep, voffA); PG8_STAGE(PG8_SB(1, 1), cB + hstep + kstep, voffB);
        PG8_WAIT_V(6); PG8_BAR;
    } else {
        PG8_STAGE(PG8_SB(0, 0), cB, voffB); PG8_STAGE(PG8_SA(0, 0), cA, voffA); PG8_STAGE(PG8_SB(0, 1), cB + hstep, voffB); PG8_STAGE(PG8_SA(0, 1), cA + hstep, voffA);
        if (wr == 1) PG8_BAR;
        PG8_WAIT_V(4); PG8_BAR;
        PG8_STAGE(PG8_SB(1, 0), cB + kstep, voffB); PG8_STAGE(PG8_SA(1, 0), cA + kstep, voffA); PG8_STAGE(PG8_SB(1, 1), cB + hstep + kstep, voffB);
        PG8_WAIT_V(6); PG8_BAR;
    }
    for (;;) {
        const bool has_next = S.next(ui + 1, nxt);
        const char* nA = has_next ? (const char*)g.A + (size_t)nxt.pm * tstep : cA; const char* nB = has_next ? (const char*)g.Bt + (size_t)nxt.pn * tstep : cB;
        for (int t = 0; t < nt; t += 2) {
            const bool last = (t == nt - 2);
            const char* a1 = cA + (size_t)(t + 1) * kstep;
            const char* a2 = last ? nA : cA + (size_t)(t + 2) * kstep; const char* b2 = last ? nB : cB + (size_t)(t + 2) * kstep;
            const char* a3 = a2 + kstep; const char* b3 = b2 + kstep;
            if (last && has_next) S.a_ready(nxt);
            if constexpr (SP2) {
            PG8_LDB(B0, 0, 0); PG8_LDB(B1, 0, 1); PG8_SCHED; PG8_LDA(At, 0, 0); PG8_STAGE(PG8_SA(1, 1), a1 + hstep, voffA);
            PG8_WAIT_V(8); PG8_WAIT_L(0); PG8_BAR; PG8_MMA(0, 0, At, B0); PG8_MMA(0, 1, At, B1); PG8_BAR; PG8_SCHED;
            PG8_LDA(At, 0, 1); PG8_STAGE(PG8_SB(0, 0), b2, voffB); PG8_STAGE(PG8_SB(0, 1), b2 + hstep, voffB); PG8_STAGE(PG8_SA(0, 0), a2, voffA);
            PG8_WAIT_V(8); PG8_WAIT_L(0); PG8_BAR; PG8_MMA(1, 0, At, B0); PG8_MMA(1, 1, At, B1); PG8_BAR; PG8_SCHED;
            PG8_LDB(B0, 1, 0); PG8_LDB(B1, 1, 1); PG8_SCHED; PG8_LDA(At, 1, 0); PG8_STAGE(PG8_SA(0, 1), a2 + hstep, voffA);
            PG8_WAIT_V(8); PG8_WAIT_L(0); PG8_BAR; PG8_MMA(0, 0, At, B0); PG8_MMA(0, 1, At, B1); PG8_BAR; PG8_SCHED;
            PG8_LDA(At, 1, 1); PG8_STAGE(PG8_SB(1, 0), b3, voffB); PG8_STAGE(PG8_SB(1, 1), b3 + hstep, voffB); PG8_STAGE(PG8_SA(1, 0), a3, voffA);
            PG8_WAIT_V(8); PG8_WAIT_L(0); PG8_BAR; PG8_MMA(1, 0, At, B0); PG8_MMA(1, 1, At, B1); PG8_BAR; PG8_SCHED;
            } else {
            PG8_LDB(B0, 0, 0); PG8_SCHED; PG8_LDA(At, 0, 0); PG8_STAGE(PG8_SA(1, 1), a1 + hstep, voffA);
            PG8_WAIT_L(8); PG8_BAR; PG8_WAIT_L(0); PG8_MMA(0, 0, At, B0); PG8_BAR; PG8_SCHED;
            PG8_LDB(B1, 0, 1); PG8_STAGE(PG8_SB(0, 0), b2, voffB);
            PG8_BAR; PG8_WAIT_L(0); PG8_MMA(0, 1, At, B1); PG8_BAR;
            PG8_LDA(At, 0, 1); PG8_STAGE(PG8_SA(0, 0), a2, voffA);
            PG8_BAR; PG8_WAIT_L(0); PG8_MMA(1, 0, At, B0); PG8_BAR; PG8_SCHED;
            PG8_STAGE(PG8_SB(0, 1), b2 + hstep, voffB);
            PG8_WAIT_V(6); PG8_BAR; PG8_MMA(1, 1, At, B1); PG8_BAR;
            PG8_LDB(B0, 1, 0); PG8_SCHED; PG8_LDA(At, 1, 0); PG8_STAGE(PG8_SA(0, 1), a2 + hstep, voffA);
            PG8_WAIT_L(8); PG8_BAR; PG8_WAIT_L(0); PG8_MMA(0, 0, At, B0); PG8_BAR; PG8_SCHED;
            PG8_LDB(B1, 1, 1); PG8_STAGE(PG8_SB(1, 0), b3, voffB);
            PG8_BAR; PG8_WAIT_L(0); PG8_MMA(0, 1, At, B1); PG8_BAR;
            PG8_LDA(At, 1, 1); PG8_STAGE(PG8_SA(1, 0), a3, voffA);
            PG8_BAR; PG8_WAIT_L(0); PG8_MMA(1, 0, At, B0); PG8_BAR; PG8_SCHED;
            PG8_STAGE(PG8_SB(1, 1), b3 + hstep, voffB);
            PG8_WAIT_V(6); PG8_BAR; PG8_MMA(1, 1, At, B1); PG8_BAR;
            }
        }
        if constexpr (ALIGN_EPI) { if (wr == 0) PG8_BAR; }
        if constexpr (!Epi::AFTER_DRAIN) { E(acc, cur, wr, wc, fr, fq); S.done(cur); }
        if (!has_next) break;
#pragma unroll
        for (int a = 0; a < 2; ++a)
#pragma unroll
            for (int b = 0; b < 2; ++b)
#pragma unroll
                for (int m = 0; m < 4; ++m)
#pragma unroll
                    for (int n = 0; n < 2; ++n) acc[a][b][m][n] = (f32x4){0.f, 0.f, 0.f, 0.f};
        cur = nxt; cA = nA; cB = nB; ++ui;
        if constexpr (ALIGN_EPI) { if (wr == 1) PG8_BAR; }
    }
    PG8_WAIT_V(0);
    if constexpr (!ALIGN_EPI) { if (wr == 0) PG8_BAR; }
    PG8_BAR;
    if constexpr (Epi::AFTER_DRAIN) { E.fused(acc, cur, wr, wc, fr, fq, lds, wid, lane); S.done(cur); }
#undef PG8_SA
#undef PG8_SB
#undef PG8_STAGE
#undef PG8_LDA
#undef PG8_LDB
#undef PG8_MMA
#undef PG8_WAIT_V
#undef PG8_WAIT_L
#undef PG8_BAR
#undef PG8_SCHED
}
}

#define LAS __attribute__((address_space(3)))
using pg8::bf16_t; using pg8::bf16x8; using pg8::f32x4; using pg8::u32x4; using pg8::Unit;
typedef float f32x16 __attribute__((ext_vector_type(16)));
typedef unsigned u32x2 __attribute__((ext_vector_type(2)));
typedef float f32x2_t __attribute__((ext_vector_type(2)));
typedef __bf16 bf16x2_t __attribute__((ext_vector_type(2)));
#define MFMA32(a, b, c) __builtin_amdgcn_mfma_f32_32x32x16_bf16((a), (b), (c), 0, 0, 0)
#define LDS_WAIT() asm volatile("s_waitcnt lgkmcnt(0)" ::: "memory")

__device__ __forceinline__ unsigned pk2(float lo, float hi) { f32x2_t v = {lo, hi}; bf16x2_t b = __builtin_convertvector(v, bf16x2_t); return __builtin_bit_cast(unsigned, b); }
__device__ __forceinline__ float bf_lo(unsigned u) { return __builtin_bit_cast(float, u << 16); }
__device__ __forceinline__ float bf_hi(unsigned u) { return __builtin_bit_cast(float, u & 0xffff0000u); }
__device__ __forceinline__ float fast_sigmoid(float x) { return __builtin_amdgcn_rcpf(1.f + __expf(-x)); }
__device__ __forceinline__ float silu(float x) { return x * fast_sigmoid(x); }
__device__ __forceinline__ float wave_sum(float v) {
#pragma unroll
    for (int o = 1; o < 64; o <<= 1) v += __shfl_xor(v, o);
    return v;
}

constexpr int DM = 1024, FF = 2816, NB = 2, SEQ = 8192, NMETA = 16, TSEQ = SEQ + NMETA;
constexpr int MMAIN = NB * SEQ;
constexpr int MTOT = MMAIN + NB * NMETA;
constexpr int MPAD = 65 * 256;
constexpr int NUP = 2 * FF;
constexpr int NIN = 2304;
constexpr int NINR = 2064;
constexpr int ZLD = 2048;
constexpr int ZC_Q = 512, ZC_K = 768, ZC_V = 1024, ZC_R = 1536;
constexpr int NCH = 129;
constexpr float ALPHA = 1.4142135623730951f;
constexpr float LN_EPS = 1e-5f, RMS_EPS = 1e-6f;

constexpr size_t MiB = 1u << 20;
constexpr size_t WS_HB = 0;
constexpr size_t WS_MIX = 33 * MiB;
constexpr size_t WS_Z = WS_MIX;
constexpr size_t WS_KVT = WS_MIX + 65 * MiB;
constexpr size_t WS_ST = WS_MIX + 98 * MiB;
constexpr size_t WS_DEC = WS_MIX + 115 * MiB;
constexpr size_t WS_G = WS_MIX;
constexpr size_t WS_W = 149 * MiB;
constexpr size_t WL_STRIDE = 40 * MiB;
constexpr size_t WO_W1A = 0, WO_W2A = 11 * MiB, WO_W1B = 33 * MiB / 2, WO_W2B = 55 * MiB / 2, WO_IN = 33 * MiB, WO_OUT = 75 * MiB / 2, WO_POOL = 79 * MiB / 2;
constexpr size_t WS_GL = 229 * MiB;
constexpr size_t WS_HM = 231 * MiB;
constexpr size_t WS_CTL = 232 * MiB, CTL_BYTES = 65536;
constexpr size_t WS_END = 233 * MiB;
static_assert((size_t)MPAD * 2816 * 2 <= 90 * MiB && (size_t)MPAD * 2048 * 2 <= 65 * MiB && (size_t)8 * NCH * 8192 * 4 <= 33 * MiB, "ws map");

constexpr int LDS_BYTES = 132096;
constexpr int NPHASES = 25;

struct Args { const float* in[21]; float* out; unsigned char* ws; int ph_lo, ph_hi; };

struct EpiAny {
    static constexpr bool PERM = true, AFTER_DRAIN = false;
    int mode; bf16_t* O; float* GL; const float* res_main; const float* res_meta; float* dst_main; float* dst_meta; float s;
    __device__ __forceinline__ void operator()(const f32x4 (&acc)[2][2][4][2], const Unit& u, int wr, int wc, int fr, int fq) const {
        if (mode == 0) {
            const int row0 = u.pm * 256 + wr * 64 + fr, col0 = u.pn * 128 + wc * 32 + 8 * fq;
#pragma unroll
            for (int ai = 0; ai < 2; ++ai)
#pragma unroll
                for (int m = 0; m < 4; ++m) {
                    const f32x4 g0 = acc[ai][0][m][0], g1 = acc[ai][0][m][1], u0 = acc[ai][1][m][0], u1 = acc[ai][1][m][1];
                    u32x4 w;
                    w.x = pk2(silu(g0[0]) * u0[0], silu(g0[1]) * u0[1]); w.y = pk2(silu(g0[2]) * u0[2], silu(g0[3]) * u0[3]);
                    w.z = pk2(silu(g1[0]) * u1[0], silu(g1[1]) * u1[1]); w.w = pk2(silu(g1[2]) * u1[2], silu(g1[3]) * u1[3]);
                    *(u32x4*)(O + (size_t)(row0 + ai * 128 + m * 16) * FF + col0) = w;
                }
        } else if (mode == 1) {
            const bool meta = u.pm >= 64;
            const float* res = meta ? res_meta : res_main; float* dst = meta ? dst_meta : dst_main;
            const int row0 = (meta ? 0 : u.pm * 256) + wr * 64 + fr, col0 = u.pn * 256 + wc * 32 + 8 * fq;
#pragma unroll
            for (int ai = 0; ai < 2; ++ai)
#pragma unroll
                for (int m = 0; m < 4; ++m) {
                    const size_t ro = (size_t)(row0 + ai * 128 + m * 16) * DM + col0;
#pragma unroll
                    for (int bj = 0; bj < 2; ++bj)
#pragma unroll
                        for (int n = 0; n < 2; ++n) {
                            const f32x4 r = *(const f32x4*)(res + ro + bj * 128 + 4 * n);
                            *(f32x4*)(dst + ro + bj * 128 + 4 * n) = r * ALPHA + acc[ai][bj][m][n] * s;
                        }
                }
        } else {
            const int row0 = u.pm * 256 + wr * 64 + fr;
            if (u.pn < 8) {
                const int col0 = u.pn * 256 + wc * 32 + 8 * fq;
#pragma unroll
                for (int ai = 0; ai < 2; ++ai)
#pragma unroll
                    for (int m = 0; m < 4; ++m)
#pragma unroll
                        for (int bj = 0; bj < 2; ++bj) {
                            const f32x4 v0 = acc[ai][bj][m][0], v1 = acc[ai][bj][m][1];
                            u32x4 w; w.x = pk2(v0[0], v0[1]); w.y = pk2(v0[2], v0[3]); w.z = pk2(v1[0], v1[1]); w.w = pk2(v1[2], v1[3]);
                            *(u32x4*)(O + (size_t)(row0 + ai * 128 + m * 16) * ZLD + col0 + bj * 128) = w;
                        }
            } else if (wc == 0 && fq < 2) {
#pragma unroll
                for (int ai = 0; ai < 2; ++ai)
#pragma unroll
                    for (int m = 0; m < 4; ++m) {
                        float* p = GL + (size_t)(row0 + ai * 128 + m * 16) * 16 + 8 * fq;
                        *(f32x4*)p = acc[ai][0][m][0]; *(f32x4*)(p + 4) = acc[ai][0][m][1];
                    }
            }
        }
    }
};

__device__ __forceinline__ void tr_item(const float* __restrict__ W, int N, bf16_t* WT, int ldt, int k0, int n0, int drow0, LAS float* scr, int lane) {
    const int nn = n0 + (lane & 31); const bool ok = nn < N;
#pragma unroll 8
    for (int i = 0; i < 32; ++i) { const int kk = 2 * i + (lane >> 5); scr[kk * 33 + (lane & 31)] = ok ? W[(size_t)(k0 + kk) * N + nn] : 0.f; }
    LDS_WAIT();
    const int c = lane & 7;
#pragma unroll
    for (int j = 0; j < 4; ++j) { const int n = (lane >> 3) + 8 * j; const LAS float* s = scr + (8 * c) * 33 + n;
        u32x4 o; o.x = pk2(s[0 * 33], s[1 * 33]); o.y = pk2(s[2 * 33], s[3 * 33]); o.z = pk2(s[4 * 33], s[5 * 33]); o.w = pk2(s[6 * 33], s[7 * 33]);
        *(u32x4*)(WT + (size_t)(drow0 + n) * ldt + k0 + 8 * c) = o; }
    LDS_WAIT();
}
constexpr int IT_FF = 16 * 88, IT_IN = 16 * 72, IT_OUT = 16 * 32, IT_POOL = 32, IT_LAYER = 6 * IT_FF + IT_IN + IT_OUT + IT_POOL;

__device__ __forceinline__ void prologue(const Args& a, LAS unsigned char* lds, int gw, int nw, int wid, int lane) {
    LAS float* scr = (LAS float*)(lds + wid * 8704);
    unsigned char* ws = a.ws;
    for (int item = gw; item < 2 * IT_LAYER; item += nw) {
        const int l = item / IT_LAYER; int r = item % IT_LAYER;
        unsigned char* wl = ws + WS_W + (size_t)l * WL_STRIDE;
        if (r < 6 * IT_FF) {
            const int which = r / IT_FF; r %= IT_FF;
            const int f = which / 3, t = which % 3;
            if (t < 2) {
                const float* W = a.in[(f ? 16 : 2) + t] + (size_t)l * DM * FF;
                const int kb = r / 88, nb = r % 88, n0 = 32 * nb;
                tr_item(W, FF, (bf16_t*)(wl + (f ? WO_W1B : WO_W1A)), DM, 64 * kb, n0, (n0 >> 7) * 256 + (n0 & 127) + 128 * t, scr, lane);
            } else {
                const float* W = a.in[f ? 18 : 4] + (size_t)l * FF * DM;
                const int kb = r / 32, nb = r % 32;
                tr_item(W, DM, (bf16_t*)(wl + (f ? WO_W2B : WO_W2A)), FF, 64 * kb, 32 * nb, 32 * nb, scr, lane);
            }
            continue;
        }
        r -= 6 * IT_FF;
        if (r < IT_IN) { const int kb = r / 72, nb = r % 72; tr_item(a.in[7] + (size_t)l * DM * NINR, NINR, (bf16_t*)(wl + WO_IN), DM, 64 * kb, 32 * nb, 32 * nb, scr, lane); continue; }
        r -= IT_IN;
        if (r < IT_OUT) { const int kb = r / 32, nb = r % 32; tr_item(a.in[13] + (size_t)l * DM * DM, DM, (bf16_t*)(wl + WO_OUT), DM, 64 * kb, 32 * nb, 32 * nb, scr, lane); continue; }
        r -= IT_OUT;
        { const int g = r >> 3, kb = (r >> 2) & 1, nb = r & 3;
          tr_item(a.in[10] + ((size_t)l * 4 + g) * 128 * 128, 128, (bf16_t*)(wl + WO_POOL), 128, 64 * kb, 32 * nb, g * 128 + 32 * nb, scr, lane); }
    }
    bf16_t* HB = (bf16_t*)(ws + WS_HB); float* HM = (float*)(ws + WS_HM);
    for (int r = gw; r < MTOT; r += nw) {
        const float* src = r < MMAIN ? a.in[0] + (size_t)r * DM : a.in[1] + (size_t)((r - MMAIN) & 15) * DM;
#pragma unroll
        for (int j = 0; j < 4; ++j) {
            const f32x4 v = *(const f32x4*)(src + 4 * lane + 256 * j);
            u32x2 o; o.x = pk2(v[0], v[1]); o.y = pk2(v[2], v[3]);
            *(u32x2*)(HB + (size_t)r * DM + 4 * lane + 256 * j) = o;
            if (r >= MMAIN) *(f32x4*)(HM + (size_t)(r - MMAIN) * DM + 4 * lane + 256 * j) = v;
        }
    }
}

__device__ __forceinline__ void ln_phase(float* Hmain, float* HM, bf16_t* HB, const float* __restrict__ g, const float* __restrict__ b, int gw, int nw, int lane) {
    f32x4 gv[4], bv[4];
#pragma unroll
    for (int j = 0; j < 4; ++j) { gv[j] = *(const f32x4*)(g + 4 * lane + 256 * j); bv[j] = *(const f32x4*)(b + 4 * lane + 256 * j); }
    for (int r = gw; r < MTOT; r += nw) {
        float* p = r < MMAIN ? Hmain + (size_t)r * DM : HM + (size_t)(r - MMAIN) * DM;
        f32x4 v[4]; float s = 0.f;
#pragma unroll
        for (int j = 0; j < 4; ++j) { v[j] = *(const f32x4*)(p + 4 * lane + 256 * j); s += (v[j][0] + v[j][1]) + (v[j][2] + v[j][3]); }
        const float mean = wave_sum(s) * (1.f / DM); float s2 = 0.f;
#pragma unroll
        for (int j = 0; j < 4; ++j) { v[j] = v[j] - mean; s2 += (v[j][0] * v[j][0] + v[j][1] * v[j][1]) + (v[j][2] * v[j][2] + v[j][3] * v[j][3]); }
        const float rstd = rsqrtf(wave_sum(s2) * (1.f / DM) + LN_EPS);
#pragma unroll
        for (int j = 0; j < 4; ++j) {
            const f32x4 y = v[j] * rstd * gv[j] + bv[j];
            *(f32x4*)(p + 4 * lane + 256 * j) = y;
            u32x2 o; o.x = pk2(y[0], y[1]); o.y = pk2(y[2], y[3]);
            *(u32x2*)(HB + (size_t)r * DM + 4 * lane + 256 * j) = o;
        }
    }
}

__device__ __forceinline__ int chunk_row(int b, int c, int i) { return c == 0 ? (i < 48 ? -1 : MMAIN + b * 16 + (i - 48)) : b * SEQ + (c - 1) * 64 + i; }
__device__ __forceinline__ int seq_row(int b, int s) { return s < NMETA ? MMAIN + b * 16 + s : b * SEQ + s - NMETA; }

__device__ __forceinline__ void gate_cumsum(const float* __restrict__ GL, const float* __restrict__ Wg, const float* __restrict__ bg, int row, int h, int w, int lane, float (&bc)[8]) {
    f32x4 g4[4];
#pragma unroll
    for (int j = 0; j < 4; ++j) g4[j] = row >= 0 ? *(const f32x4*)(GL + (size_t)row * 16 + 4 * j) : (f32x4){0.f, 0.f, 0.f, 0.f};
    const float* wp = Wg + h * 64 + 8 * w; const float* bp = bg + h * 64 + 8 * w;
#pragma unroll
    for (int i = 0; i < 8; ++i) {
        float x = bp[i];
#pragma unroll
        for (int r = 0; r < 16; ++r) x += g4[r >> 2][r & 3] * wp[r * 256 + i];
        float la = (fminf(x, 0.f) - __logf(1.f + __expf(-fabsf(x)))) * (1.f / 16.f);
        if (row < 0) la = 0.f;
#pragma unroll
        for (int off = 1; off < 64; off <<= 1) { const float t = __shfl_up(la, off); if (lane >= off) la += t; }
        bc[i] = la;
    }
}

constexpr int L_QE = 0, L_KE = 9216, L_VT = 18432, L_RED = 36864, LROW = 72;

__device__ __forceinline__ void stage_vT(const bf16_t* __restrict__ Z, int row, int h, int w, int lane, LAS unsigned char* lds) {
    u32x4 v0 = {0, 0, 0, 0}, v1 = {0, 0, 0, 0};
    if (row >= 0) { const bf16_t* p = Z + (size_t)row * ZLD + ZC_V + h * 128 + 16 * w; v0 = *(const u32x4*)p; v1 = *(const u32x4*)(p + 8); }
    LAS bf16_t* vt = (LAS bf16_t*)(lds + L_VT) + (16 * w) * LROW + lane;
#pragma unroll
    for (int i = 0; i < 4; ++i) { vt[(2 * i) * LROW] = (bf16_t)(v0[i] & 0xffffu); vt[(2 * i + 1) * LROW] = (bf16_t)(v0[i] >> 16);
                                  vt[(8 + 2 * i) * LROW] = (bf16_t)(v1[i] & 0xffffu); vt[(9 + 2 * i) * LROW] = (bf16_t)(v1[i] >> 16); }
}

__device__ __forceinline__ void mixa_phase(const Args& a, int l, LAS unsigned char* lds, int wid, int lane) {
    unsigned char* ws = a.ws;
    const bf16_t* Z = (const bf16_t*)(ws + WS_Z); const float* GL = (const float*)(ws + WS_GL);
    float* KVT = (float*)(ws + WS_KVT); float* DEC = (float*)(ws + WS_DEC);
    const float* Wg = a.in[8] + (size_t)l * 16 * 256; const float* bg = a.in[9] + (size_t)l * 256;
    const int l31 = lane & 31, hi = lane >> 5;
    for (int u = blockIdx.x; u < 2 * 128 * 4; u += gridDim.x) {
        const int h = u & 3, c = (u >> 2) & 127, b = u >> 9, bh = b * 4 + h;
        const int row = chunk_row(b, c, lane);
        float bc[8]; gate_cumsum(GL, Wg, bg, row, h, wid, lane, bc);
        u32x4 kv = {0, 0, 0, 0};
        if (row >= 0) kv = *(const u32x4*)(Z + (size_t)row * ZLD + ZC_K + h * 64 + 8 * wid);
        LAS bf16_t* kdt = (LAS bf16_t*)(lds + L_KE) + (8 * wid) * LROW + lane;
#pragma unroll
        for (int i = 0; i < 8; ++i) {
            const float bl = __shfl(bc[i], 63);
            const float kf = (i & 1) ? bf_hi(kv[i >> 1]) : bf_lo(kv[i >> 1]);
            kdt[i * LROW] = (bf16_t)(pk2(kf * __expf(bl - bc[i]), 0.f) & 0xffffu);
            if (lane == 63) DEC[(size_t)(bh * NCH + c) * 64 + 8 * wid + i] = __expf(bl);
        }
        stage_vT(Z, row, h, wid, lane, lds);
        __syncthreads();
        const int eb = wid >> 1, db = wid & 1;
        f32x16 acc = {0.f, 0.f, 0.f, 0.f, 0.f, 0.f, 0.f, 0.f, 0.f, 0.f, 0.f, 0.f, 0.f, 0.f, 0.f, 0.f};
#pragma unroll
        for (int s = 0; s < 4; ++s) {
            const bf16x8 A = *(const LAS bf16x8*)(lds + L_VT + ((eb * 32 + l31) * LROW + 16 * s + 8 * hi) * 2);
            const bf16x8 B = *(const LAS bf16x8*)(lds + L_KE + ((db * 32 + l31) * LROW + 16 * s + 8 * hi) * 2);
            acc = MFMA32(A, B, acc);
        }
        float* o = KVT + ((size_t)(bh * NCH + c) * 128 + eb * 32 + 4 * hi) * 64 + db * 32 + l31;
#pragma unroll
        for (int r = 0; r < 16; ++r) o[((r & 3) + 8 * (r >> 2)) * 64] = acc[r];
        __syncthreads();
    }
}

__device__ __forceinline__ void mixb_phase(const Args& a, int l, int wid, int lane) {
    unsigned char* ws = a.ws;
    const int G = gridDim.x;
    {
        const float* __restrict__ KVT = (const float*)(ws + WS_KVT); const float* __restrict__ DEC = (const float*)(ws + WS_DEC);
        bf16_t* __restrict__ ST = (bf16_t*)(ws + WS_ST);
        for (int gw = wid * G + blockIdx.x; gw < 1024; gw += 8 * G) {
            const int rec = gw * 64 + lane, bh = rec >> 13, ed = rec & 8191, d = ed & 63;
            const float* kp = KVT + (size_t)bh * NCH * 8192 + ed; const float* dp = DEC + (size_t)bh * NCH * 64 + d; bf16_t* sp = ST + (size_t)bh * NCH * 8192 + 8192 + ed;
            float S = 0.f;
#pragma unroll 16
            for (int c = 0; c < 128; ++c) { S = S * dp[(size_t)c * 64] + kp[(size_t)c * 8192]; sp[(size_t)c * 8192] = (bf16_t)(pk2(S, 0.f) & 0xffffu); }
        }
    }
    {
        const bf16_t* __restrict__ Z = (const bf16_t*)(ws + WS_Z); bf16_t* Y = (bf16_t*)(ws + WS_HB);
        const bf16_t* __restrict__ WPT = (const bf16_t*)(ws + WS_W + (size_t)l * WL_STRIDE + WO_POOL);
        const float* __restrict__ psc = a.in[11] + (size_t)l * 512;
        const int l31 = lane & 31, hi = lane >> 5;
        for (int pu = (7 - wid) * G + blockIdx.x; pu < 2 * 257 * 4; pu += 8 * G) {
            const int g = pu & 3, blk = (pu >> 2) % 257, b = (pu >> 2) / 257;
            const int pos = 32 * blk + l31; const bool valid = pos < TSEQ;
            const int w = 2 << g; const float inv = 1.f / (float)min(pos + 1, w);
            f32x16 acc[4];
#pragma unroll
            for (int nb = 0; nb < 4; ++nb) acc[nb] = (f32x16){0.f, 0.f, 0.f, 0.f, 0.f, 0.f, 0.f, 0.f, 0.f, 0.f, 0.f, 0.f, 0.f, 0.f, 0.f, 0.f};
            for (int ks = 0; ks < 8; ++ks) {
                const int c0 = g * 128 + 16 * ks + 8 * hi;
                float sum[8], self[8];
#pragma unroll
                for (int i = 0; i < 8; ++i) { sum[i] = 0.f; self[i] = 0.f; }
                for (int j = 0; j < w; ++j) {
                    const int ps = pos - j;
                    if (valid && ps >= 0) {
                        const u32x4 v = *(const u32x4*)(Z + (size_t)seq_row(b, ps) * ZLD + c0);
#pragma unroll
                        for (int i = 0; i < 4; ++i) { sum[2 * i] += bf_lo(v[i]); sum[2 * i + 1] += bf_hi(v[i]); }
                        if (j == 0) {
#pragma unroll
                            for (int i = 0; i < 4; ++i) { self[2 * i] = bf_lo(v[i]); self[2 * i + 1] = bf_hi(v[i]); }
                        }
                    }
                }
                u32x4 pa;
#pragma unroll
                for (int i = 0; i < 4; ++i) pa[i] = pk2(sum[2 * i] * inv - self[2 * i], sum[2 * i + 1] * inv - self[2 * i + 1]);
                const bf16x8 A = __builtin_bit_cast(bf16x8, pa);
#pragma unroll
                for (int nb = 0; nb < 4; ++nb) {
                    const bf16x8 B = *(const bf16x8*)(WPT + (size_t)(g * 128 + nb * 32 + l31) * 128 + 16 * ks + 8 * hi);
                    acc[nb] = MFMA32(A, B, acc[nb]);
                }
            }
#pragma unroll
            for (int r = 0; r < 16; ++r) {
                const int p2 = 32 * blk + (r & 3) + 8 * (r >> 2) + 4 * hi;
                if (p2 < TSEQ) {
                    bf16_t* yo = Y + (size_t)seq_row(b, p2) * DM + g * 128 + l31;
#pragma unroll
                    for (int nb = 0; nb < 4; ++nb) yo[nb * 32] = (bf16_t)(pk2(acc[nb][r] * psc[g * 128 + nb * 32 + l31], 0.f) & 0xffffu);
                }
            }
        }
    }
}

__device__ __forceinline__ void mixc_phase(const Args& a, int l, LAS unsigned char* lds, int wid, int lane) {
    unsigned char* ws = a.ws;
    const bf16_t* Z = (const bf16_t*)(ws + WS_Z); const float* GL = (const float*)(ws + WS_GL);
    const bf16_t* ST = (const bf16_t*)(ws + WS_ST); bf16_t* Y = (bf16_t*)(ws + WS_HB);
    const float* Wg = a.in[8] + (size_t)l * 16 * 256; const float* bg = a.in[9] + (size_t)l * 256;
    const float* gn = a.in[12] + (size_t)l * 512;
    const int l31 = lane & 31, hi = lane >> 5;
    for (int u = blockIdx.x; u < 2 * NCH * 4; u += gridDim.x) {
        const int h = u & 3, c = (u >> 2) % NCH, b = (u >> 2) / NCH, bh = b * 4 + h;
        const int row = chunk_row(b, c, lane);
        float bc[8]; gate_cumsum(GL, Wg, bg, row, h, wid, lane, bc);
        u32x4 qv = {0, 0, 0, 0}, kv = {0, 0, 0, 0};
        if (row >= 0) { const bf16_t* p = Z + (size_t)row * ZLD + h * 64 + 8 * wid; qv = *(const u32x4*)(p + ZC_Q); kv = *(const u32x4*)(p + ZC_K); }
        u32x4 qo, ko;
#pragma unroll
        for (int i = 0; i < 4; ++i) {
            const float e0 = __expf(bc[2 * i]), e1 = __expf(bc[2 * i + 1]), n0 = __expf(-bc[2 * i]), n1 = __expf(-bc[2 * i + 1]);
            qo[i] = pk2(bf_lo(qv[i]) * e0 * 0.125f, bf_hi(qv[i]) * e1 * 0.125f);
            ko[i] = pk2(bf_lo(kv[i]) * n0, bf_hi(kv[i]) * n1);
        }
        *(LAS u32x4*)(lds + L_QE + (lane * LROW + 8 * wid) * 2) = qo;
        *(LAS u32x4*)(lds + L_KE + (lane * LROW + 8 * wid) * 2) = ko;
        stage_vT(Z, row, h, wid, lane, lds);
        __syncthreads();
        const int eb = wid & 3, ib = wid >> 2;
        f32x16 acc = {0.f, 0.f, 0.f, 0.f, 0.f, 0.f, 0.f, 0.f, 0.f, 0.f, 0.f, 0.f, 0.f, 0.f, 0.f, 0.f};
        if (c > 0) {
            const bf16_t* sp = ST + ((size_t)(bh * NCH + c) * 128 + eb * 32 + l31) * 64 + 8 * hi;
#pragma unroll
            for (int s = 0; s < 4; ++s) {
                const bf16x8 A = *(const bf16x8*)(sp + 16 * s);
                const bf16x8 B = *(const LAS bf16x8*)(lds + L_QE + ((ib * 32 + l31) * LROW + 16 * s + 8 * hi) * 2);
                acc = MFMA32(A, B, acc);
            }
        }
        for (int jb = 0; jb <= ib; ++jb) {
            f32x16 p = {0.f, 0.f, 0.f, 0.f, 0.f, 0.f, 0.f, 0.f, 0.f, 0.f, 0.f, 0.f, 0.f, 0.f, 0.f, 0.f};
#pragma unroll
            for (int s = 0; s < 4; ++s) {
                const bf16x8 A = *(const LAS bf16x8*)(lds + L_KE + ((jb * 32 + l31) * LROW + 16 * s + 8 * hi) * 2);
                const bf16x8 B = *(const LAS bf16x8*)(lds + L_QE + ((ib * 32 + l31) * LROW + 16 * s + 8 * hi) * 2);
                p = MFMA32(A, B, p);
            }
            if (jb == ib) {
#pragma unroll
                for (int r = 0; r < 16; ++r) if ((r & 3) + 8 * (r >> 2) + 4 * hi > l31) p[r] = 0.f;
            }
#pragma unroll
            for (int s2 = 0; s2 < 2; ++s2) {
                u32x4 pb;
#pragma unroll
                for (int i = 0; i < 4; ++i) pb[i] = pk2(p[8 * s2 + 2 * i], p[8 * s2 + 2 * i + 1]);
                const LAS unsigned char* vp = lds + L_VT + ((eb * 32 + l31) * LROW + jb * 32 + 16 * s2 + 4 * hi) * 2;
                const u32x2 a0 = *(const LAS u32x2*)vp, a1 = *(const LAS u32x2*)(vp + 16);
                const u32x4 pa = {a0.x, a0.y, a1.x, a1.y};
                acc = MFMA32(__builtin_bit_cast(bf16x8, pa), __builtin_bit_cast(bf16x8, pb), acc);
            }
        }
        float ss = 0.f;
#pragma unroll
        for (int r = 0; r < 16; ++r) ss += acc[r] * acc[r];
        ss += __shfl_xor(ss, 32);
        LAS float* red = (LAS float*)(lds + L_RED);
        if (hi == 0) red[eb * 64 + ib * 32 + l31] = ss;
        __syncthreads();
        const int ti = ib * 32 + l31;
        const float tot = (red[ti] + red[64 + ti]) + (red[128 + ti] + red[192 + ti]);
        const float rstd = rsqrtf(tot * (1.f / 128.f) + RMS_EPS);
        const int orow = chunk_row(b, c, ti);
        if (orow >= 0) {
#pragma unroll
            for (int rg = 0; rg < 4; ++rg) {
                const int e0 = h * 128 + eb * 32 + 8 * rg + 4 * hi;
                const u32x2 rv = *(const u32x2*)(Z + (size_t)orow * ZLD + ZC_R + e0);
                const f32x4 gv = *(const f32x4*)(gn + e0);
                u32x2 o;
                o.x = pk2(acc[4 * rg] * rstd * gv[0] * silu(bf_lo(rv.x)), acc[4 * rg + 1] * rstd * gv[1] * silu(bf_hi(rv.x)));
                o.y = pk2(acc[4 * rg + 2] * rstd * gv[2] * silu(bf_lo(rv.y)), acc[4 * rg + 3] * rstd * gv[3] * silu(bf_hi(rv.y)));
                *(u32x2*)(Y + (size_t)orow * DM + 512 + e0) = o;
            }
        }
        __syncthreads();
    }
}

#define XB_TMO      128
#define XB_XCNT(j)  (256  + 64 * (j))
#define XB_XSUB(j)  (1280 + 64 * (j))
#define XB_XGEN(j)  (2304 + 64 * (j))
#define XB_TOP      3328
#define XB_TOPGEN   3392
#define XCD_BAR_WORDS 3456
#define XB_SPIN_CAP (1u << 18)

__device__ __forceinline__ unsigned xb_ld(unsigned* p)              { return __hip_atomic_load(p, __ATOMIC_RELAXED, __HIP_MEMORY_SCOPE_AGENT); }
__device__ __forceinline__ unsigned xb_add(unsigned* p, unsigned v) { return __hip_atomic_fetch_add(p, v, __ATOMIC_RELAXED, __HIP_MEMORY_SCOPE_AGENT); }
__device__ __forceinline__ unsigned xb_xcc_id() { return (unsigned)__builtin_amdgcn_s_getreg((3 << 11) | 20) & 0xFu; }
#define XB_SPIN(cond, bar) do { unsigned _sp = 0; while (cond) { __builtin_amdgcn_s_sleep(1); \
    if ((++_sp & 255u) == 0u) { if (xb_ld(&(bar)[XB_TMO])) break; if (_sp > XB_SPIN_CAP) { atomicAdd(&(bar)[XB_TMO], 1u); break; } } } } while (0)

struct XcdBarrier {
    unsigned* bar; unsigned x;
    volatile LAS unsigned* st;
};

__device__ __forceinline__ XcdBarrier xcd_barrier_post(unsigned* bar, volatile LAS unsigned* st) {
    XcdBarrier b; b.bar = bar; b.x = xb_xcc_id(); b.st = st;
    if (threadIdx.x == 0) (void)xb_add(&bar[XB_XCNT(b.x)], 1u);
    return b;
}
__device__ __forceinline__ void xcd_barrier_complete(unsigned* bar, unsigned x, unsigned& nloc, unsigned& nx) {
    const unsigned G = gridDim.x * gridDim.y * gridDim.z;
    unsigned sum, cnt, mine, sp = 0u;
    for (;;) {
        sum = 0u; cnt = 0u; mine = 0u;
#pragma unroll
        for (unsigned j = 0; j < 16; ++j) { const unsigned c = xb_ld(&bar[XB_XCNT(j)]); sum += c; cnt += (c > 0u) ? 1u : 0u; mine = (j == x) ? c : mine; }
        if (sum == G) break;
        __builtin_amdgcn_s_sleep(1);
        if ((++sp & 255u) == 0u) { if (xb_ld(&bar[XB_TMO])) break; if (sp > XB_SPIN_CAP) { atomicAdd(&bar[XB_TMO], 1u); break; } }
    }
    nloc = mine > 0u ? mine : 1u; nx = cnt > 0u ? cnt : 1u;
}

__device__ __forceinline__ void xcd_barrier(const XcdBarrier& b) {
    asm volatile("s_waitcnt vmcnt(0)" ::: "memory");
    __syncthreads();
    if (threadIdx.x == 0) {
        unsigned* bar = b.bar;
        __builtin_amdgcn_s_waitcnt(0);
        unsigned nloc = b.st[0], nx = b.st[1];
        if (nloc == 0u) { xcd_barrier_complete(bar, b.x, nloc, nx); b.st[0] = nloc; b.st[1] = nx; }
        const unsigned old = xb_add(&bar[XB_XSUB(b.x)], 1u);
        const unsigned gen = old / nloc;
        if (old + 1u == (gen + 1u) * nloc) {
            __builtin_amdgcn_fence(__ATOMIC_RELEASE, "agent");
            asm volatile("s_waitcnt vmcnt(0)" ::: "memory");
            const unsigned og = xb_add(&bar[XB_TOP], 1u);
            const unsigned tg = og / nx;
            if (og + 1u == (tg + 1u) * nx) xb_add(&bar[XB_TOPGEN], 1u);
            else XB_SPIN(xb_ld(&bar[XB_TOPGEN]) == tg, bar);
            __builtin_amdgcn_fence(__ATOMIC_ACQUIRE, "agent");
            xb_add(&bar[XB_XGEN(b.x)], 1u);
            asm volatile("s_waitcnt vmcnt(0)" ::: "memory");
        } else {
            XB_SPIN(xb_ld(&bar[XB_XGEN(b.x)]) == gen, bar);
            __builtin_amdgcn_fence(__ATOMIC_ACQUIRE, "agent");
            asm volatile("s_waitcnt vmcnt(0)" ::: "memory");
        }
    }
    __syncthreads();
}


__global__ void __launch_bounds__(512, 2) fwd_kernel(Args a) {
    extern __shared__ __attribute__((aligned(16))) unsigned char lds_raw[];
    LAS unsigned char* lds = (LAS unsigned char*)lds_raw;
    volatile LAS unsigned* bst = (volatile LAS unsigned*)(lds + 131072 + 512);
    if (threadIdx.x == 0) { bst[0] = 0u; bst[1] = 0u; }
    __syncthreads();
    XcdBarrier bar = xcd_barrier_post((unsigned*)(a.ws + WS_CTL), bst);
    for (int ph = a.ph_lo; ph < a.ph_hi; ++ph) {
        int tid = threadIdx.x; asm volatile("" : "+v"(tid));
        const int lane = tid & 63, wid = __builtin_amdgcn_readfirstlane(tid >> 6);
        const int G = gridDim.x, gw = blockIdx.x * 8 + wid, nw = G * 8;
        unsigned char* ws = a.ws; asm volatile("" : "+s"(ws));
        bf16_t* HB = (bf16_t*)(ws + WS_HB); float* HM = (float*)(ws + WS_HM);
        if (ph == 0) {
            for (int rep = 0; rep < PROBE_P; ++rep) prologue(a, lds, gw, nw, wid, lane);
        } else {
            const int q = ph - 1, l = q / 12, p = q % 12;
            unsigned char* wl = ws + WS_W + (size_t)l * WL_STRIDE;
            if (p == 0 || p == 9 || p == 1 || p == 7 || p == 10 || p == 3) {
                const int mode = (p == 0 || p == 9) ? 0 : (p == 3 ? 2 : 1);
                const bool outp = (p == 7);
                const bf16_t* A = (mode == 1 && !outp) ? (const bf16_t*)(ws + WS_G) : HB;
                const size_t wo = p == 0 ? WO_W1A : p == 9 ? WO_W1B : p == 1 ? WO_W2A : p == 10 ? WO_W2B : p == 7 ? WO_OUT : WO_IN;
                const int N = mode == 0 ? NUP : (mode == 2 ? NIN : DM), K = (mode == 1 && !outp) ? FF : DM;
                pg8::Gemm g{A, (const bf16_t*)(wl + wo), MPAD, N, K};
                pg8::StaticOrder S; S.init(MPAD, N, G, (int)blockIdx.x);
                EpiAny E{mode, (bf16_t*)(ws + (mode == 0 ? WS_G : WS_Z)), (float*)(ws + WS_GL), (l == 0 && p == 1) ? a.in[0] : a.out, HM, a.out, HM, outp ? 1.0f : 0.5f};
                pg8::gemm_phase<EpiAny, pg8::StaticOrder, true, true>(lds, g, S, E);
            } else if (p == 2 || p == 8 || p == 11) {
                const int gi = p == 2 ? 5 : (p == 8 ? 14 : 19);
                ln_phase(a.out, HM, HB, a.in[gi] + (size_t)l * DM, a.in[gi + 1] + (size_t)l * DM, gw, nw, lane);
            } else if (p == 4) { for (int rep = 0; rep < PROBE_A; ++rep) mixa_phase(a, l, lds, wid, lane);
            } else if (p == 5) { for (int rep = 0; rep < PROBE_B; ++rep) mixb_phase(a, l, wid, lane);
            } else { for (int rep = 0; rep < PROBE_C; ++rep) mixc_phase(a, l, lds, wid, lane); }
        }
        if (ph + 1 < a.ph_hi) { if (ph == 0) cg::this_grid().sync(); else xcd_barrier(bar); }
    }
}

extern "C" void kernel_launch(void* const* d_in, const int* in_sizes, int n_in, void* d_out, int out_size, void* d_ws, size_t ws_size, hipStream_t stream) {
    static int grid = 0;
    if (grid == 0) {
        if (n_in != 21 || out_size != MMAIN * DM || ws_size < WS_END) { fprintf(stderr, "kernel_launch: unexpected shapes (n_in %d, out %d, ws %zu)\n", n_in, out_size, ws_size); grid = -1; return; }
        int dev = 0, cus = 0, per_cu = 0;
        if (hipGetDevice(&dev) != hipSuccess || hipDeviceGetAttribute(&cus, hipDeviceAttributeMultiprocessorCount, dev) != hipSuccess) { grid = -1; return; }
        if (hipFuncSetAttribute((const void*)fwd_kernel, hipFuncAttributeMaxDynamicSharedMemorySize, LDS_BYTES) != hipSuccess) { fprintf(stderr, "kernel_launch: hipFuncSetAttribute failed\n"); grid = -1; return; }
        if (hipOccupancyMaxActiveBlocksPerMultiprocessor(&per_cu, (const void*)fwd_kernel, 512, LDS_BYTES) != hipSuccess || per_cu < 1) { fprintf(stderr, "kernel_launch: occupancy query gave %d\n", per_cu); per_cu = 1; }
        (void)hipGetLastError();
        grid = cus * per_cu;
    }
    if (grid < 0) return;
    Args a{};
    for (int i = 0; i < 21; ++i) a.in[i] = (const float*)d_in[i];
    a.out = (float*)d_out; a.ws = (unsigned char*)d_ws;
#if ONE_LAUNCH
    if (hipMemsetAsync((char*)d_ws + WS_CTL, 0, CTL_BYTES, stream) != hipSuccess) { fprintf(stderr, "kernel_launch: memset failed\n"); return; }
    a.ph_lo = 0; a.ph_hi = NPHASES;
    void* args[] = {&a};
    hipError_t e = hipLaunchCooperativeKernel((const void*)fwd_kernel, dim3(grid), dim3(512), args, LDS_BYTES, stream);
    if (e != hipSuccess) fprintf(stderr, "kernel_launch: cooperative launch failed: %s (grid %d)\n", hipGetErrorString(e), grid);
#else
    for (int ph = 0; ph < NPHASES; ++ph) {
        a.ph_lo = ph; a.ph_hi = ph + 1;
        hipLaunchKernelGGL(fwd_kernel, dim3(grid), dim3(512), LDS_BYTES, stream, a);
    }
#endif
}
```
